# Optimizing an MI355X kernel written in HIP

```python
import jax, jax.numpy as jnp
from jax import lax
import numpy as np

D_MODEL = 1024
BATCH = 8
SEQ = 2048
DEPTH = 1

C_CONV = 512
CONV_WIDTH = 31
N_HEADS = 8
HEAD_DIM = 64
H_IDX = 8
D_IDX = 64
TOPK_MAX = 256
Q_BLOCK = 128
D_FF = 2816
N_BRANCH = 2
RMS_EPS = 1e-6
LN_EPS = 1e-5

IN_SIZES = (2 * C_CONV, N_HEADS * HEAD_DIM, HEAD_DIM, HEAD_DIM, H_IDX * D_IDX, D_IDX, H_IDX, N_BRANCH * D_MODEL)
N_IN = 2 * C_CONV + N_HEADS * HEAD_DIM + 2 * HEAD_DIM + H_IDX * D_IDX + D_IDX + H_IDX + N_BRANCH * D_MODEL

kernel_name = "hybrid_conformer_conv_dsa_gated_block"


def _rmsnorm(x, g):
    x32 = x.astype(jnp.float32)
    y = x32 * lax.rsqrt(jnp.mean(x32 * x32, axis=-1, keepdims=True) + RMS_EPS)
    return (y * g.astype(jnp.float32)).astype(x.dtype)


def _layernorm(x, g, b):
    x32 = x.astype(jnp.float32)
    mu = jnp.mean(x32, axis=-1, keepdims=True)
    xc = x32 - mu
    y = xc * lax.rsqrt(jnp.mean(xc * xc, axis=-1, keepdims=True) + LN_EPS)
    return (y * g.astype(jnp.float32) + b.astype(jnp.float32)).astype(x.dtype)


def _alibi_slopes(n):
    return jnp.exp2(-8.0 * jnp.arange(1, n + 1, dtype=jnp.float32) / n)


def _split_cols(u):
    parts, off = [], 0
    for sz in IN_SIZES:
        parts.append(u[..., off:off + sz])
        off += sz
    return parts


def _conv_module(u, conv_w, conv_b, ln_g, ln_b, w_pw_out):
    a, gt = u[..., :C_CONV], u[..., C_CONV:]
    h = a * jax.nn.sigmoid(gt)
    h = lax.conv_general_dilated(
        h, conv_w[:, None, :].astype(h.dtype), window_strides=(1,),
        padding=[(CONV_WIDTH - 1, 0)],
        dimension_numbers=('NWC', 'WIO', 'NWC'), feature_group_count=C_CONV) + conv_b
    h = jax.nn.silu(_layernorm(h, ln_g, ln_b))
    return h @ w_pw_out


def _dsa_attention(q, k, v, q_idx, k_idx, w_idx, slopes):
    B, L = q.shape[0], q.shape[1]
    topk = min(TOPK_MAX, L // 4)
    nb = L // Q_BLOCK

    def to_blocks(a):
        return jnp.moveaxis(a.reshape((B, nb, Q_BLOCK) + a.shape[2:]), 1, 0)

    s_pos = jnp.arange(L)
    gather = jax.vmap(lambda table, ii: table[ii])

    def block(xs):
        start, qb, qib, wb = xs
        t = start + jnp.arange(Q_BLOCK)
        causal = s_pos[None, :] <= t[:, None]
        rel = jax.nn.relu(jnp.einsum('bqhd,bsd->bqhs', qib, k_idx))
        score = jnp.einsum('bqh,bqhs->bqs', wb, rel).astype(jnp.float32)
        score = jnp.where(causal[None], score, -jnp.inf)
        _, idx = lax.top_k(score, topk)
        k_sel = gather(k, idx)
        v_sel = gather(v, idx)
        att = jnp.einsum('bqhd,bqkd->bhqk', qb, k_sel).astype(jnp.float32) * (HEAD_DIM ** -0.5)
        dist = (t[None, :, None] - idx).astype(jnp.float32)
        att = att - slopes[None, :, None, None] * dist[:, None]
        valid = (idx <= t[None, :, None])[:, None]
        att = jnp.where(valid, att, -jnp.inf)
        p = jax.nn.softmax(att, axis=-1).astype(v.dtype)
        return jnp.einsum('bhqk,bqkd->bqhd', p, v_sel)

    starts = jnp.arange(nb, dtype=jnp.int32) * Q_BLOCK
    out = lax.map(block, (starts, to_blocks(q), to_blocks(q_idx), to_blocks(w_idx)))
    return jnp.moveaxis(out, 0, 1).reshape(B, L, N_HEADS * HEAD_DIM)


def setup_inputs(seed: int = 0) -> dict:
    key = jax.random.key(seed)
    ks = jax.random.split(key, 20)
    f32 = jnp.float32

    def nrm(k, shape, fan_in):
        return jax.random.normal(k, shape, f32) * (fan_in ** -0.5)

    def gain(k, shape):
        return 1.0 + 0.02 * jax.random.normal(k, shape, f32)

    return {
        "x": jax.random.normal(ks[0], (BATCH, SEQ, D_MODEL), f32),
        "norm_mix": gain(ks[1], (DEPTH, D_MODEL)),
        "w_in": nrm(ks[2], (DEPTH, D_MODEL, N_IN), D_MODEL),
        "b_gate": 0.02 * jax.random.normal(ks[3], (DEPTH, N_BRANCH * D_MODEL), f32),
        "conv_w": nrm(ks[4], (DEPTH, CONV_WIDTH, C_CONV), CONV_WIDTH),
        "conv_b": 0.02 * jax.random.normal(ks[5], (DEPTH, C_CONV), f32),
        "conv_ln_g": gain(ks[6], (DEPTH, C_CONV)),
        "conv_ln_b": 0.02 * jax.random.normal(ks[7], (DEPTH, C_CONV), f32),
        "w_conv_out": nrm(ks[8], (DEPTH, C_CONV, D_MODEL), C_CONV),
        "w_attn_out": nrm(ks[9], (DEPTH, N_HEADS * HEAD_DIM, D_MODEL), N_HEADS * HEAD_DIM),
        "w_out": nrm(ks[10], (DEPTH, D_MODEL, D_MODEL), D_MODEL),
        "norm_ffn": gain(ks[11], (DEPTH, D_MODEL)),
        "w_ffn_gate": nrm(ks[12], (DEPTH, D_MODEL, D_FF), D_MODEL),
        "w_ffn_up": nrm(ks[13], (DEPTH, D_MODEL, D_FF), D_MODEL),
        "w_ffn_down": nrm(ks[14], (DEPTH, D_FF, D_MODEL), D_FF),
        "norm_final": gain(ks[15], (D_MODEL,)),
    }


def reference(x, norm_mix, w_in, b_gate, conv_w, conv_b, conv_ln_g, conv_ln_b,
              w_conv_out, w_attn_out, w_out, norm_ffn, w_ffn_gate, w_ffn_up,
              w_ffn_down, norm_final):
    B, L, _ = x.shape
    slopes = _alibi_slopes(N_HEADS)
    for layer in range(DEPTH):
        h = _rmsnorm(x, norm_mix[layer])
        u = h @ w_in[layer]
        u_conv, u_q, u_k, u_v, u_qi, u_ki, u_wi, u_g = _split_cols(u)
        y_conv = _conv_module(u_conv, conv_w[layer], conv_b[layer], conv_ln_g[layer],
                              conv_ln_b[layer], w_conv_out[layer])
        q = u_q.reshape(B, L, N_HEADS, HEAD_DIM)
        q_idx = u_qi.reshape(B, L, H_IDX, D_IDX) * (D_IDX ** -0.5)
        w_idx = u_wi * (H_IDX ** -0.5)
        y_attn = _dsa_attention(q, u_k, u_v, q_idx, u_ki, w_idx, slopes) @ w_attn_out[layer]
        g = jax.nn.sigmoid(u_g + b_gate[layer])
        merged = g[..., :D_MODEL] * y_conv + g[..., D_MODEL:] * y_attn
        x = x + merged @ w_out[layer]
        hf = _rmsnorm(x, norm_ffn[layer])
        x = x + (jax.nn.silu(hf @ w_ffn_gate[layer]) * (hf @ w_ffn_up[layer])) @ w_ffn_down[layer]
    return _rmsnorm(x, norm_final)
```

```cpp
#include <hip/hip_runtime.h>
#include <cstdint>
#include <cstdio>

namespace v0 {
constexpr int D = 1024, B = 8, L = 2048, M = B * L;
constexpr int CC = 512, CW = 31, NH = 8, HD = 64, HI = 8, DI = 64, TOPK = 256, DFF = 2816;
constexpr int N_IN = 2 * CC + NH * HD + 2 * HD + HI * DI + DI + HI + 2 * D;
constexpr int O_CONV = 0, O_Q = 1024, O_K = 1536, O_V = 1600, O_QI = 1664, O_KI = 2176, O_WI = 2240, O_G = 2248;
constexpr int NAT = 1224;

__device__ __forceinline__ float wsum(float v) {
#pragma unroll
    for (int o = 32; o > 0; o >>= 1) v += __shfl_xor(v, o);
    return v;
}

__global__ void rmsnorm_k(const float* __restrict__ x, const float* __restrict__ g, float* __restrict__ y, int rows) {
    const int w = (blockIdx.x * blockDim.x + threadIdx.x) >> 6, lane = threadIdx.x & 63;
    if (w >= rows) return;
    const float* xr = x + (size_t)w * D; float v[16]; float s = 0.f;
#pragma unroll
    for (int j = 0; j < 16; ++j) { v[j] = xr[lane + 64 * j]; s += v[j] * v[j]; }
    s = wsum(s); const float r = 1.0f / sqrtf(s * (1.0f / D) + 1e-6f);
#pragma unroll
    for (int j = 0; j < 16; ++j) y[(size_t)w * D + lane + 64 * j] = v[j] * r * g[lane + 64 * j];
}

__global__ void __launch_bounds__(256) gemm_k(const float* __restrict__ A, int lda, const float* __restrict__ Bm, int ldb, float* __restrict__ C, int ldc, int N, int K, int accum) {
    __shared__ float As[16][64 + 4], Bs[16][64 + 4];
    const int tx = threadIdx.x & 15, ty = threadIdx.x >> 4, m0 = blockIdx.y * 64, n0 = blockIdx.x * 64;
    float acc[4][4] = {};
    for (int k0 = 0; k0 < K; k0 += 16) {
        {
            const int r = threadIdx.x >> 2, kq = (threadIdx.x & 3) * 4;
            const float4 a = *(const float4*)(A + (size_t)(m0 + r) * lda + k0 + kq);
            As[kq + 0][r] = a.x; As[kq + 1][r] = a.y; As[kq + 2][r] = a.z; As[kq + 3][r] = a.w;
            const int kk = threadIdx.x >> 4, nq = (threadIdx.x & 15) * 4;
#pragma unroll
            for (int j = 0; j < 4; ++j) { const int n = n0 + nq + j; Bs[kk][nq + j] = (n < N) ? Bm[(size_t)(k0 + kk) * ldb + n] : 0.f; }
        }
        __syncthreads();
#pragma unroll
        for (int kk = 0; kk < 16; ++kk) {
            float a[4], b[4];
#pragma unroll
            for (int i = 0; i < 4; ++i) { a[i] = As[kk][ty * 4 + i]; b[i] = Bs[kk][tx * 4 + i]; }
#pragma unroll
            for (int i = 0; i < 4; ++i)
#pragma unroll
                for (int j = 0; j < 4; ++j) acc[i][j] += a[i] * b[j];
        }
        __syncthreads();
    }
#pragma unroll
    for (int i = 0; i < 4; ++i)
#pragma unroll
        for (int j = 0; j < 4; ++j) { const int n = n0 + tx * 4 + j; if (n < N) { float* p = C + (size_t)(m0 + ty * 4 + i) * ldc + n; *p = accum ? (*p + acc[i][j]) : acc[i][j]; } }
}

__device__ __forceinline__ float sigm(float x) { return 1.0f / (1.0f + expf(-x)); }

__global__ void glu_k(const float* __restrict__ u, float* __restrict__ glu) {
    const size_t i = (size_t)blockIdx.x * blockDim.x + threadIdx.x; if (i >= (size_t)M * CC) return;
    const size_t m = i / CC; const int c = (int)(i % CC);
    glu[i] = u[m * 1024 + c] * sigm(u[m * 1024 + CC + c]);
}
__global__ void conv_k(const float* __restrict__ glu, const float* __restrict__ w, const float* __restrict__ bias, float* __restrict__ out) {
    const size_t i = (size_t)blockIdx.x * blockDim.x + threadIdx.x; if (i >= (size_t)M * CC) return;
    const int m = (int)(i / CC), c = (int)(i % CC), b = m / L, t = m % L;
    float s = bias[c];
    for (int j = 0; j < CW; ++j) { const int tt = t - (CW - 1) + j; if (tt >= 0) s += w[j * CC + c] * glu[((size_t)b * L + tt) * CC + c]; }
    out[i] = s;
}
__global__ void lnsilu_k(const float* __restrict__ x, const float* __restrict__ g, const float* __restrict__ bb, float* __restrict__ y) {
    const int w = (blockIdx.x * blockDim.x + threadIdx.x) >> 6, lane = threadIdx.x & 63; if (w >= M) return;
    float v[8]; float s = 0.f;
#pragma unroll
    for (int j = 0; j < 8; ++j) { v[j] = x[(size_t)w * CC + lane + 64 * j]; s += v[j]; }
    const float mu = wsum(s) * (1.0f / CC); float q = 0.f;
#pragma unroll
    for (int j = 0; j < 8; ++j) { v[j] -= mu; q += v[j] * v[j]; }
    const float r = 1.0f / sqrtf(wsum(q) * (1.0f / CC) + 1e-5f);
#pragma unroll
    for (int j = 0; j < 8; ++j) { const float z = v[j] * r * g[lane + 64 * j] + bb[lane + 64 * j]; y[(size_t)w * CC + lane + 64 * j] = z * sigm(z); }
}

__device__ __forceinline__ unsigned fkey(float f) { f += 0.0f; const unsigned u = __float_as_uint(f); return (u & 0x80000000u) ? ~u : (u | 0x80000000u); }

__global__ void __launch_bounds__(256) dsa_k(const float* __restrict__ uat, float* __restrict__ aout) {
    __shared__ unsigned keys[L];
    __shared__ float qs[512], ws_[8], att[8][256], mh[8], lh[8];
    __shared__ int sel[256];
    __shared__ unsigned cnt_s, pos_s;
    const int m = blockIdx.x, b = m / L, t = m % L, tid = threadIdx.x;
    const float* row = uat + (size_t)m * NAT;
    for (int i = tid; i < 512; i += 256) qs[i] = row[640 + i] * 0.125f;
    if (tid < 8) ws_[tid] = row[1216 + tid] * 0.35355339059327373f;
    __syncthreads();
    for (int s = tid; s < L; s += 256) {
        unsigned key = 0u;
        if (s <= t) {
            const float* kr = uat + ((size_t)b * L + s) * NAT + 1152; float sc = 0.f;
            for (int h = 0; h < 8; ++h) { float d = 0.f; for (int e = 0; e < 64; ++e) d += qs[h * 64 + e] * kr[e]; sc += ws_[h] * fmaxf(d, 0.f); }
            key = fkey(sc);
        }
        keys[s] = key;
    }
    __syncthreads();
    const int nsel = (t + 1 < TOPK) ? (t + 1) : TOPK;
    if (t + 1 <= TOPK) { for (int s = tid; s <= t; s += 256) sel[s] = s; }
    else {
        unsigned T = 0u;
        for (int bit = 31; bit >= 0; --bit) {
            const unsigned cand = T | (1u << bit);
            if (tid == 0) cnt_s = 0u;
            __syncthreads();
            unsigned c = 0; for (int s = tid; s < L; s += 256) c += (keys[s] >= cand);
            if (c) atomicAdd(&cnt_s, c);
            __syncthreads();
            if (cnt_s >= (unsigned)TOPK) T = cand;
            __syncthreads();
        }
        if (tid == 0) { int p = 0; for (int s = 0; s <= t; ++s) if (keys[s] > T) sel[p++] = s; for (int s = 0; s <= t && p < TOPK; ++s) if (keys[s] == T) sel[p++] = s; }
    }
    __syncthreads();
    for (int i = tid; i < 512; i += 256) qs[i] = row[i];
    __syncthreads();
    {
        const int k = tid;
        if (k < nsel) {
            const int s = sel[k]; const float* kr = uat + ((size_t)b * L + s) * NAT + 512;
            for (int h = 0; h < 8; ++h) { float d = 0.f; for (int e = 0; e < 64; ++e) d += qs[h * 64 + e] * kr[e];
                const float slope = exp2f(-(float)(h + 1)); att[h][k] = d * 0.125f - slope * (float)(t - s); }
        }
    }
    __syncthreads();
    if (tid < 8) { float mx = -INFINITY; for (int k = 0; k < nsel; ++k) mx = fmaxf(mx, att[tid][k]); float l = 0.f; for (int k = 0; k < nsel; ++k) l += expf(att[tid][k] - mx); mh[tid] = mx; lh[tid] = l; }
    __syncthreads();
    for (int i = tid; i < 8 * 256; i += 256) { const int h = i >> 8, k = i & 255; att[h][k] = (k < nsel) ? expf(att[h][k] - mh[h]) / lh[h] : 0.f; }
    __syncthreads();
    for (int o = tid; o < 512; o += 256) { const int h = o >> 6, d = o & 63; float a = 0.f;
        for (int k = 0; k < nsel; ++k) a += att[h][k] * uat[((size_t)b * L + sel[k]) * NAT + 576 + d];
        aout[(size_t)m * 512 + o] = a; }
}

__global__ void gate_k(const float* __restrict__ ug, const float* __restrict__ bg, const float* __restrict__ y, float* __restrict__ mg, int accum) {
    const size_t i = (size_t)blockIdx.x * blockDim.x + threadIdx.x; if (i >= (size_t)M * D) return;
    const int c = (int)(i % D); const float v = sigm(ug[i] + bg[c]) * y[i]; mg[i] = accum ? mg[i] + v : v;
}
__global__ void add_k(const float* __restrict__ a, const float* __restrict__ b, float* __restrict__ o, size_t n) { const size_t i = (size_t)blockIdx.x * blockDim.x + threadIdx.x; if (i < n) o[i] = a[i] + b[i]; }
__global__ void swiglu_k(float* __restrict__ g, const float* __restrict__ u, size_t n) { const size_t i = (size_t)blockIdx.x * blockDim.x + threadIdx.x; if (i < n) { const float x = g[i]; g[i] = x * sigm(x) * u[i]; } }

static void gemm(hipStream_t st, const float* A, int lda, const float* Bm, int ldb, float* C, int ldc, int N, int K, int accum) {
    dim3 grid((N + 63) / 64, M / 64); hipLaunchKernelGGL(gemm_k, grid, dim3(256), 0, st, A, lda, Bm, ldb, C, ldc, N, K, accum);
}
}

extern "C" void kernel_launch(void* const* d_in, const int* in_sizes, int n_in, void* d_out, int out_size, void* d_ws, size_t ws_size, hipStream_t stream) {
    using namespace v0;
    const float* x = (const float*)d_in[0]; const float* norm_mix = (const float*)d_in[1]; const float* w_in = (const float*)d_in[2]; const float* b_gate = (const float*)d_in[3];
    const float* conv_w = (const float*)d_in[4]; const float* conv_b = (const float*)d_in[5]; const float* ln_g = (const float*)d_in[6]; const float* ln_b = (const float*)d_in[7];
    const float* w_co = (const float*)d_in[8]; const float* w_ao = (const float*)d_in[9]; const float* w_out = (const float*)d_in[10]; const float* norm_ffn = (const float*)d_in[11];
    const float* w_fg = (const float*)d_in[12]; const float* w_fu = (const float*)d_in[13]; const float* w_fd = (const float*)d_in[14]; const float* norm_final = (const float*)d_in[15];
    float* out = (float*)d_out; float* ws = (float*)d_ws;
    const size_t MD = (size_t)M * D;
    float* rA = ws;
    float* rB = ws + MD;
    float* rC = ws + 2 * MD;
    float* rD = ws + 3 * MD;
    const int EB = 256;
    hipLaunchKernelGGL(rmsnorm_k, dim3(M / 4), dim3(256), 0, stream, x, norm_mix, rA, M);
    gemm(stream, rA, D, w_in + O_CONV, N_IN, rB, 1024, 1024, D, 0);
    float* glu = rC; float* cfin = rC + MD / 2; float* craw = rB;
    hipLaunchKernelGGL(glu_k, dim3((unsigned)((MD / 2 + EB - 1) / EB)), dim3(EB), 0, stream, rB, glu);
    hipLaunchKernelGGL(conv_k, dim3((unsigned)((MD / 2 + EB - 1) / EB)), dim3(EB), 0, stream, glu, conv_w, conv_b, craw);
    hipLaunchKernelGGL(lnsilu_k, dim3(M / 4), dim3(256), 0, stream, craw, ln_g, ln_b, cfin);
    float* uat = rB;
    gemm(stream, rA, D, w_in + O_Q, N_IN, uat, NAT, NAT, D, 0);
    float* aout = rD;
    hipLaunchKernelGGL(dsa_k, dim3(M), dim3(256), 0, stream, uat, aout);
    gemm(stream, cfin, CC, w_co, D, rB, D, D, CC, 0);
    gemm(stream, aout, CC, w_ao, D, rC, D, D, CC, 0);
    gemm(stream, rA, D, w_in + O_G, N_IN, rD, D, D, D, 0);
    hipLaunchKernelGGL(gate_k, dim3((unsigned)((MD + EB - 1) / EB)), dim3(EB), 0, stream, rD, b_gate, rB, rB, 0);
    gemm(stream, rA, D, w_in + O_G + D, N_IN, rD, D, D, D, 0);
    hipLaunchKernelGGL(gate_k, dim3((unsigned)((MD + EB - 1) / EB)), dim3(EB), 0, stream, rD, b_gate + D, rC, rB, 1);
    gemm(stream, rB, D, w_out, D, rC, D, D, D, 0);
    hipLaunchKernelGGL(add_k, dim3((unsigned)((MD + EB - 1) / EB)), dim3(EB), 0, stream, x, rC, out, MD);
    hipLaunchKernelGGL(rmsnorm_k, dim3(M / 4), dim3(256), 0, stream, out, norm_ffn, rA, M);
    for (int c = 0; c < 4; ++c) {
        const int n0 = c * 704;
        gemm(stream, rA, D, w_fg + n0, DFF, rB, 704, 704, D, 0);
        gemm(stream, rA, D, w_fu + n0, DFF, rC, 704, 704, D, 0);
        const size_t n = (size_t)M * 704;
        hipLaunchKernelGGL(swiglu_k, dim3((unsigned)((n + EB - 1) / EB)), dim3(EB), 0, stream, rB, rC, n);
        gemm(stream, rB, 704, w_fd + (size_t)n0 * D, D, out, D, D, 704, 1);
    }
    hipLaunchKernelGGL(rmsnorm_k, dim3(M / 4), dim3(256), 0, stream, out, norm_final, rD, M);
    hipMemcpyAsync(out, rD, MD * sizeof(float), hipMemcpyDeviceToDevice, stream);
}
```

```cpp
#include <hip/hip_runtime.h>
#include <cstdio>
#include <cstdint>
#include <cmath>
namespace pg8 {
#define PG8_LAS __attribute__((address_space(3)))
typedef unsigned short bf16_t;
typedef short bf16x8 __attribute__((ext_vector_type(8)));
typedef float f32x4 __attribute__((ext_vector_type(4)));
typedef unsigned u32x4 __attribute__((ext_vector_type(4)));
constexpr int BM = 256, BK = 64, HALF = 128, HTB = HALF * BK * 2  , STAGE_BYTES = 8 * HTB, NXCD = 8, WGM = 8;

__host__ __device__ __forceinline__ int lds_byte(int r, int c) { const int st = (r >> 4) * 2 + (c >> 5), rr = r & 15, cc = c & 31, ob = rr * 64 + cc * 2; return st * 1024 + (ob ^ (((ob >> 9) & 1) << 5)); }
__host__ __device__ __forceinline__ void stage_rc(int b, int& R, int& C) { const int st = b / 1024, sb = b % 1024, swz = sb ^ (((sb >> 9) & 1) << 5); R = (st >> 1) * 16 + swz / 64; C = (st & 1) * 32 + (swz % 64) / 2; }
__host__ __device__ __forceinline__ int perm32(int rho) { const int n = rho >> 4, i = rho & 15; return 8 * (i >> 2) + 4 * n + (i & 3); }

struct Unit { int pm, pn; };
struct Gemm { const bf16_t* A; const bf16_t* Bt; int M, N, K; };

struct StaticOrder {
    int nM, nN, nwg, G, c;
    __host__ __device__ void init(int M, int N, int G_, int c_) { nM = M / BM; nN = N / BM; nwg = nM * nN; G = G_; c = c_; }
    __host__ __device__ bool next(int i, Unit& u) const {
        const long L = (long)i * G + c; if (L >= nwg) return false;
        int wgid = (int)L; { const int q = nwg / NXCD, r = nwg % NXCD, xcd = wgid % NXCD, off = wgid / NXCD; wgid = (xcd < r ? xcd * (q + 1) : r * (q + 1) + (xcd - r) * q) + off; }
        const int nig = WGM * nN, gid = wgid / nig, fm = gid * WGM, gsz = (nM - fm) < WGM ? (nM - fm) : WGM;
        u.pm = fm + ((wgid % nig) % gsz); u.pn = (wgid % nig) / gsz; return true;
    }
    __device__ __forceinline__ void a_ready(const Unit&) const {}
    __device__ __forceinline__ void done(const Unit&) const {}
};

typedef float f32x2cv __attribute__((ext_vector_type(2)));
typedef __bf16 bf16x2cv __attribute__((ext_vector_type(2)));
__device__ __forceinline__ unsigned cvt_pk_bf16(float lo, float hi) { const f32x2cv v = {lo, hi}; const bf16x2cv b = __builtin_convertvector(v, bf16x2cv); return __builtin_bit_cast(unsigned, b); }
typedef float f32x2 __attribute__((ext_vector_type(2)));
__device__ __forceinline__ float bf_lo(unsigned w) { return __uint_as_float(w << 16); }
__device__ __forceinline__ float bf_hi(unsigned w) { return __uint_as_float(w & 0xffff0000u); }
__device__ __forceinline__ float fsigmoid(float x) { return __builtin_amdgcn_rcpf(1.0f + __expf(-x)); }
__device__ __forceinline__ u32x4 pack8(const f32x4 a, const f32x4 b) { u32x4 w; w.x = cvt_pk_bf16(a[0], a[1]); w.y = cvt_pk_bf16(a[2], a[3]); w.z = cvt_pk_bf16(b[0], b[1]); w.w = cvt_pk_bf16(b[2], b[3]); return w; }
__device__ __forceinline__ void unpack8(const u32x4 w, f32x4& a, f32x4& b) { a = (f32x4){bf_lo(w.x), bf_hi(w.x), bf_lo(w.y), bf_hi(w.y)}; b = (f32x4){bf_lo(w.z), bf_hi(w.z), bf_lo(w.w), bf_hi(w.w)}; }
__device__ __forceinline__ f32x4 sig4(const f32x4 v) { return (f32x4){fsigmoid(v[0]), fsigmoid(v[1]), fsigmoid(v[2]), fsigmoid(v[3])}; }

struct EpiU {
    static constexpr bool PERM = true, AFTER_DRAIN = false;
    bf16_t *GLU, *Q, *QI, *Kb, *Vb, *KI, *G; float* WI; const float* bgate; float qsc;
    __device__ __forceinline__ void operator()(const f32x4 (&acc)[2][2][4][2], const Unit& u, int wr, int wc, int fr, int fq) const {
        const int pn = u.pn, row0 = u.pm * BM + wr * 64 + fr, cl = wc * 32 + 8 * fq;
        if (pn < 4) {
#pragma unroll
            for (int ai = 0; ai < 2; ++ai)
#pragma unroll
                for (int m = 0; m < 4; ++m) { const size_t row = (size_t)(row0 + ai * HALF + m * 16);
                    const f32x4 r0 = acc[ai][0][m][0] * sig4(acc[ai][1][m][0]), r1 = acc[ai][0][m][1] * sig4(acc[ai][1][m][1]);
                    *(u32x4*)(GLU + row * 512 + pn * 128 + cl) = pack8(r0, r1); }
        } else if (pn < 8) {
            bf16_t* base = (pn < 6) ? Q : QI; const float sc = (pn < 6) ? qsc : 0.125f; const int c0 = ((pn - 4) & 1) * 256 + cl;
#pragma unroll
            for (int ai = 0; ai < 2; ++ai)
#pragma unroll
                for (int m = 0; m < 4; ++m) { const size_t row = (size_t)(row0 + ai * HALF + m * 16);
#pragma unroll
                    for (int bj = 0; bj < 2; ++bj) *(u32x4*)(base + row * 512 + c0 + bj * HALF) = pack8(acc[ai][bj][m][0] * sc, acc[ai][bj][m][1] * sc); }
        } else if (pn == 8) {
#pragma unroll
            for (int ai = 0; ai < 2; ++ai)
#pragma unroll
                for (int m = 0; m < 4; ++m) { const size_t row = (size_t)(row0 + ai * HALF + m * 16);
                    bf16_t* d0 = (wc < 2) ? (Kb + row * 64 + cl) : (Vb + row * 64 + (cl - 64));
                    *(u32x4*)d0 = pack8(acc[ai][0][m][0], acc[ai][0][m][1]);
                    if (wc < 2) *(u32x4*)(KI + row * 64 + cl) = pack8(acc[ai][1][m][0], acc[ai][1][m][1]);
                    else if (wc == 2 && fq == 0) { *(f32x4*)(WI + row * 8) = acc[ai][1][m][0] * 0.35355339059327373f; *(f32x4*)(WI + row * 8 + 4) = acc[ai][1][m][1] * 0.35355339059327373f; } }
        } else {
            const int gc = (pn - 9) * 256 + cl;
            f32x4 bv[2][2];
#pragma unroll
            for (int bj = 0; bj < 2; ++bj)
#pragma unroll
                for (int n = 0; n < 2; ++n) bv[bj][n] = *(const f32x4*)(bgate + gc + bj * HALF + 4 * n);
#pragma unroll
            for (int ai = 0; ai < 2; ++ai)
#pragma unroll
                for (int m = 0; m < 4; ++m) { const size_t row = (size_t)(row0 + ai * HALF + m * 16);
#pragma unroll
                    for (int bj = 0; bj < 2; ++bj) *(u32x4*)(G + row * 2048 + gc + bj * HALF) = pack8(sig4(acc[ai][bj][m][0] + bv[bj][0]), sig4(acc[ai][bj][m][1] + bv[bj][1])); }
        }
    }
};
template <bool SECOND> struct EpiMix {
    static constexpr bool PERM = true, AFTER_DRAIN = false;
    const bf16_t* G; bf16_t* T1; bf16_t* MG;
    __device__ __forceinline__ void operator()(const f32x4 (&acc)[2][2][4][2], const Unit& u, int wr, int wc, int fr, int fq) const {
        const int row0 = u.pm * BM + wr * 64 + fr, c0 = u.pn * BM + wc * 32 + 8 * fq;
#pragma unroll
        for (int ai = 0; ai < 2; ++ai)
#pragma unroll
            for (int m = 0; m < 4; ++m) { const size_t row = (size_t)(row0 + ai * HALF + m * 16);
#pragma unroll
                for (int bj = 0; bj < 2; ++bj) { const int c = c0 + bj * HALF;
                    f32x4 g0, g1; unpack8(*(const u32x4*)(G + row * 2048 + (SECOND ? 1024 : 0) + c), g0, g1);
                    f32x4 r0 = g0 * acc[ai][bj][m][0], r1 = g1 * acc[ai][bj][m][1];
                    if (SECOND) { f32x4 t0, t1; unpack8(*(const u32x4*)(T1 + row * 1024 + c), t0, t1); r0 += t0; r1 += t1; *(u32x4*)(MG + row * 1024 + c) = pack8(r0, r1); }
                    else *(u32x4*)(T1 + row * 1024 + c) = pack8(r0, r1); } }
    }
};
template <bool WB16> struct EpiRes {
    static constexpr bool PERM = true, AFTER_DRAIN = false;
    const float* base; float* out; bf16_t* xb; float* SS;
    __device__ __forceinline__ void operator()(const f32x4 (&acc)[2][2][4][2], const Unit& u, int wr, int wc, int fr, int fq) const {
        const int row0 = u.pm * BM + wr * 64 + fr, c0 = u.pn * BM + wc * 32 + 8 * fq;
#pragma unroll
        for (int ai = 0; ai < 2; ++ai)
#pragma unroll
            for (int m = 0; m < 4; ++m) { const size_t row = (size_t)(row0 + ai * HALF + m * 16); float s = 0.f;
#pragma unroll
                for (int bj = 0; bj < 2; ++bj) { const size_t o = row * 1024 + c0 + bj * HALF;
                    const f32x4 r0 = *(const f32x4*)(base + o) + acc[ai][bj][m][0], r1 = *(const f32x4*)(base + o + 4) + acc[ai][bj][m][1];
                    *(f32x4*)(out + o) = r0; *(f32x4*)(out + o + 4) = r1;
                    if (WB16) *(u32x4*)(xb + o) = pack8(r0, r1);
                    s += (r0[0] * r0[0] + r0[1] * r0[1]) + (r0[2] * r0[2] + r0[3] * r0[3]) + (r1[0] * r1[0] + r1[1] * r1[1]) + (r1[2] * r1[2] + r1[3] * r1[3]); }
                s += __shfl_xor(s, 16); s += __shfl_xor(s, 32);
                if (fq == 0) SS[row * 16 + u.pn * 4 + wc] = s; }
    }
};
struct EpiFF {
    static constexpr bool PERM = true, AFTER_DRAIN = false;
    bf16_t* H; const float* SS; int ldh;
    __device__ __forceinline__ void operator()(const f32x4 (&acc)[2][2][4][2], const Unit& u, int wr, int wc, int fr, int fq) const {
        const int row0 = u.pm * BM + wr * 64 + fr, cl = u.pn * 128 + wc * 32 + 8 * fq;
#pragma unroll
        for (int ai = 0; ai < 2; ++ai)
#pragma unroll
            for (int m = 0; m < 4; ++m) { const size_t row = (size_t)(row0 + ai * HALF + m * 16);
                const f32x4 s0 = *(const f32x4*)(SS + row * 16), s1 = *(const f32x4*)(SS + row * 16 + 4), s2 = *(const f32x4*)(SS + row * 16 + 8), s3 = *(const f32x4*)(SS + row * 16 + 12);
                const f32x4 st = (s0 + s1) + (s2 + s3); const float ss = (st[0] + st[1]) + (st[2] + st[3]);
                const float rstd = __builtin_amdgcn_rsqf(ss * (1.0f / 1024.0f) + 1e-6f);
                const f32x4 g0 = acc[ai][0][m][0] * rstd, g1 = acc[ai][0][m][1] * rstd, u0 = acc[ai][1][m][0] * rstd, u1 = acc[ai][1][m][1] * rstd;
                *(u32x4*)(H + row * ldh + cl) = pack8(g0 * sig4(g0) * u0, g1 * sig4(g1) * u1); }
    }
};
template <class Epi, class Sched, bool ALIGN_EPI = false, bool SP2 = false>
__device__ __forceinline__ void gemm_phase(PG8_LAS unsigned char* lds, const Gemm g, const Sched& S, const Epi& E) {
    const int tid = threadIdx.x, wid = __builtin_amdgcn_readfirstlane(tid >> 6), lane = tid & 63, wr = wid >> 2, wc = wid & 3, fr = lane & 15, fq = lane >> 4;
    const int K = g.K, nt = K / BK;
    unsigned voffA[2], voffB[2];
#pragma unroll
    for (int i = 0; i < 2; ++i) { int R, C; stage_rc(tid * 16 + i * 8192, R, C); const int Rb = Epi::PERM ? ((R & ~31) + perm32(R & 31)) : R;
        voffA[i] = (unsigned)(R * K + C) * 2u; voffB[i] = (unsigned)(Rb * K + C) * 2u; }
    const size_t kstep = (size_t)(BK * 2);
    const size_t hstep = (size_t)HALF * K * 2;
    const size_t tstep = 2 * hstep;
    const unsigned ldsw = (unsigned)wid * 1024u;
    const int aoff = lds_byte(wr * 64 + fr, fq * 8), boff = lds_byte(wc * 32 + fr, fq * 8);
#define PG8_SA(b, h) (((b) * 2 + (h)) * HTB)
#define PG8_SB(b, h) ((4 + (b) * 2 + (h)) * HTB)
#define PG8_STAGE(bufoff, gbase, voff) do { _Pragma("unroll") for (int _i = 0; _i < 2; ++_i) \
        __builtin_amdgcn_global_load_lds((const unsigned*)((const char*)(gbase) + (voff)[_i]), (PG8_LAS unsigned*)(lds + (bufoff) + ldsw + _i * 8192), 16, 0, 0); } while (0)
#define PG8_LDA(dst, b, h) do { _Pragma("unroll") for (int m = 0; m < 4; ++m) _Pragma("unroll") for (int k = 0; k < 2; ++k) dst[m][k] = *(const PG8_LAS bf16x8*)(lds + PG8_SA(b, h) + aoff + m * 2048 + k * 1024); } while (0)
#define PG8_LDB(dst, b, h) do { _Pragma("unroll") for (int n = 0; n < 2; ++n) _Pragma("unroll") for (int k = 0; k < 2; ++k) dst[n][k] = *(const PG8_LAS bf16x8*)(lds + PG8_SB(b, h) + boff + n * 2048 + k * 1024); } while (0)
#define PG8_MMA(ai, bj, At, Bt) do { __builtin_amdgcn_s_setprio(1); _Pragma("unroll") for (int m = 0; m < 4; ++m) _Pragma("unroll") for (int n = 0; n < 2; ++n) _Pragma("unroll") for (int k = 0; k < 2; ++k) \
        acc[ai][bj][m][n] = __builtin_amdgcn_mfma_f32_16x16x32_bf16(Bt[n][k], At[m][k], acc[ai][bj][m][n], 0, 0, 0); __builtin_amdgcn_s_setprio(0); } while (0)
#define PG8_WAIT_V(n) asm volatile("s_waitcnt vmcnt(" #n ")" ::: "memory")
#define PG8_WAIT_L(n) asm volatile("s_waitcnt lgkmcnt(" #n ")" ::: "memory")
#define PG8_BAR __builtin_amdgcn_s_barrier()
#define PG8_SCHED __builtin_amdgcn_sched_barrier(0)
    Unit cur, nxt; int ui = 0;
    if (!S.next(0, cur)) return;
    f32x4 acc[2][2][4][2];
#pragma unroll
    for (int a = 0; a < 2; ++a)
#pragma unroll
        for (int b = 0; b < 2; ++b)
#pragma unroll
            for (int m = 0; m < 4; ++m)
#pragma unroll
                for (int n = 0; n < 2; ++n) acc[a][b][m][n] = (f32x4){0.f, 0.f, 0.f, 0.f};
    bf16x8 At[4][2], B0[2][2], B1[2][2];
    const char* cA = (const char*)g.A + (size_t)cur.pm * tstep; const char* cB = (const char*)g.Bt + (size_t)cur.pn * tstep;
    S.a_ready(cur);
    if constexpr (SP2) {
        PG8_STAGE(PG8_SB(0, 0), cB, voffB); PG8_STAGE(PG8_SB(0, 1), cB + hstep, voffB); PG8_STAGE(PG8_SA(0, 0), cA, voffA); PG8_STAGE(PG8_SA(0, 1), cA + hstep, voffA);
        if (wr == 1) PG8_BAR;
        PG8_WAIT_V(2); PG8_BAR;
        PG8_STAGE(PG8_SB(1, 0), cB + kstep, voffB); PG8_STAGE(PG8_SA(1, 0), cA + kstep, voffA); PG8_STAGE(PG8_SB(1, 1), cB + hstep + kstep, voffB);
        PG8_WAIT_V(6); PG8_BAR;
    } else {
        PG8_STAGE(PG8_SB(0, 0), cB, voffB); PG8_STAGE(PG8_SA(0, 0), cA, voffA); PG8_STAGE(PG8_SB(0, 1), cB + hstep, voffB); PG8_STAGE(PG8_SA(0, 1), cA + hstep, voffA);
        if (wr == 1) PG8_BAR;
        PG8_WAIT_V(4); PG8_BAR;
        PG8_STAGE(PG8_SB(1, 0), cB + kstep, voffB); PG8_STAGE(PG8_SA(1, 0), cA + kstep, voffA); PG8_STAGE(PG8_SB(1, 1), cB + hstep + kstep, voffB);
        PG8_WAIT_V(6); PG8_BAR;
    }
    for (;;) {
        const bool has_next = S.next(ui + 1, nxt);
        const char* nA = has_next ? (const char*)g.A + (size_t)nxt.pm * tstep : cA; const char* nB = has_next ? (const char*)g.Bt + (size_t)nxt.pn * tstep : cB;
        for (int t = 0; t < nt; t += 2) {
            const bool last = (t == nt - 2);
            const char* a1 = cA + (size_t)(t + 1) * kstep;
            const char* a2 = last ? nA : cA + (size_t)(t + 2) * kstep; const char* b2 = last ? nB : cB + (size_t)(t + 2) * kstep;
            const char* a3 = a2 + kstep; const char* b3 = b2 + kstep;
            if (last && has_next) S.a_ready(nxt);
            if constexpr (SP2) {
            PG8_LDB(B0, 0, 0); PG8_LDB(B1, 0, 1); PG8_SCHED; PG8_LDA(At, 0, 0); PG8_STAGE(PG8_SA(1, 1), a1 + hstep, voffA);
            PG8_WAIT_V(8); PG8_WAIT_L(0); PG8_BAR; PG8_MMA(0, 0, At, B0); PG8_MMA(0, 1, At, B1); PG8_BAR; PG8_SCHED;
            PG8_LDA(At, 0, 1); PG8_STAGE(PG8_SB(0, 0), b2, voffB); PG8_STAGE(PG8_SB(0, 1), b2 + hstep, voffB); PG8_STAGE(PG8_SA(0, 0), a2, voffA);
            PG8_WAIT_V(8); PG8_WAIT_L(0); PG8_BAR; PG8_MMA(1, 0, At, B0); PG8_MMA(1, 1, At, B1); PG8_BAR; PG8_SCHED;
            PG8_LDB(B0, 1, 0); PG8_LDB(B1, 1, 1); PG8_SCHED; PG8_LDA(At, 1, 0); PG8_STAGE(PG8_SA(0, 1), a2 + hstep, voffA);
            PG8_WAIT_V(8); PG8_WAIT_L(0); PG8_BAR; PG8_MMA(0, 0, At, B0); PG8_MMA(0, 1, At, B1); PG8_BAR; PG8_SCHED;
            PG8_LDA(At, 1, 1); PG8_STAGE(PG8_SB(1, 0), b3, voffB); PG8_STAGE(PG8_SB(1, 1), b3 + hstep, voffB); PG8_STAGE(PG8_SA(1, 0), a3, voffA);
            PG8_WAIT_V(8); PG8_WAIT_L(0); PG8_BAR; PG8_MMA(1, 0, At, B0); PG8_MMA(1, 1, At, B1); PG8_BAR; PG8_SCHED;
            } else {
            PG8_LDB(B0, 0, 0); PG8_SCHED; PG8_LDA(At, 0, 0); PG8_STAGE(PG8_SA(1, 1), a1 + hstep, voffA);
            PG8_WAIT_L(8); PG8_BAR; PG8_WAIT_L(0); PG8_MMA(0, 0, At, B0); PG8_BAR; PG8_SCHED;
            PG8_LDB(B1, 0, 1); PG8_STAGE(PG8_SB(0, 0), b2, voffB);
            PG8_BAR; PG8_WAIT_L(0); PG8_MMA(0, 1, At, B1); PG8_BAR;
            PG8_LDA(At, 0, 1); PG8_STAGE(PG8_SA(0, 0), a2, voffA);
            PG8_BAR; PG8_WAIT_L(0); PG8_MMA(1, 0, At, B0); PG8_BAR; PG8_SCHED;
            PG8_STAGE(PG8_SB(0, 1), b2 + hstep, voffB);
            PG8_WAIT_V(6); PG8_BAR; PG8_MMA(1, 1, At, B1); PG8_BAR;
            PG8_LDB(B0, 1, 0); PG8_SCHED; PG8_LDA(At, 1, 0); PG8_STAGE(PG8_SA(0, 1), a2 + hstep, voffA);
            PG8_WAIT_L(8); PG8_BAR; PG8_WAIT_L(0); PG8_MMA(0, 0, At, B0); PG8_BAR; PG8_SCHED;
            PG8_LDB(B1, 1, 1); PG8_STAGE(PG8_SB(1, 0), b3, voffB);
            PG8_BAR; PG8_WAIT_L(0); PG8_MMA(0, 1, At, B1); PG8_BAR;
            PG8_LDA(At, 1, 1); PG8_STAGE(PG8_SA(1, 0), a3, voffA);
            PG8_BAR; PG8_WAIT_L(0); PG8_MMA(1, 0, At, B0); PG8_BAR; PG8_SCHED;
            PG8_STAGE(PG8_SB(1, 1), b3 + hstep, voffB);
            PG8_WAIT_V(6); PG8_BAR; PG8_MMA(1, 1, At, B1); PG8_BAR;
            }
        }
        if constexpr (ALIGN_EPI) { if (wr == 0) PG8_BAR; }
        if constexpr (!Epi::AFTER_DRAIN) { E(acc, cur, wr, wc, fr, fq); S.done(cur); }
        if (!has_next) break;
#pragma unroll
        for (int a = 0; a < 2; ++a)
#pragma unroll
            for (int b = 0; b < 2; ++b)
#pragma unroll
                for (int m = 0; m < 4; ++m)
#pragma unroll
                    for (int n = 0; n < 2; ++n) acc[a][b][m][n] = (f32x4){0.f, 0.f, 0.f, 0.f};
        cur = nxt; cA = nA; cB = nB; ++ui;
        if constexpr (ALIGN_EPI) { if (wr == 1) PG8_BAR; }
    }
    PG8_WAIT_V(0);
    if constexpr (!ALIGN_EPI) { if (wr == 0) PG8_BAR; }
    PG8_BAR;
    if constexpr (Epi::AFTER_DRAIN) { E.fused(acc, cur, wr, wc, fr, fq, lds, wid, lane); S.done(cur); }
#undef PG8_SA
#undef PG8_SB
#undef PG8_STAGE
#undef PG8_LDA
#undef PG8_LDB
#undef PG8_MMA
#undef PG8_WAIT_V
#undef PG8_WAIT_L
#undef PG8_BAR
#undef PG8_SCHED
}
}
#define GAS __attribute__((address_space(1)))
#define LAS __attribute__((address_space(3)))
typedef unsigned short bf16;
typedef unsigned v4u __attribute__((ext_vector_type(4)));
typedef float f32x4 __attribute__((ext_vector_type(4)));
typedef short bf16x8 __attribute__((ext_vector_type(8)));
typedef GAS unsigned gu32;
typedef GAS unsigned long long gu64;
#define RLX_AGENT __ATOMIC_RELAXED, __HIP_MEMORY_SCOPE_AGENT
#define LDS_WAIT() asm volatile("s_waitcnt lgkmcnt(0)" ::: "memory")
#define VM_WAIT() asm volatile("s_waitcnt vmcnt(0)" ::: "memory")
__device__ __forceinline__ unsigned long long rt() { return __builtin_amdgcn_s_memrealtime(); }
__device__ __forceinline__ unsigned f2bf(float f) { unsigned u = __builtin_bit_cast(unsigned, f); return (u + 0x7fffu + ((u >> 16) & 1u)) >> 16; }
__device__ __forceinline__ unsigned pk2(float lo, float hi) { return f2bf(lo) | (f2bf(hi) << 16); }

#define XB_TMO      128
#define XB_XCNT(j)  (256  + 64 * (j))
#define XB_XSUB(j)  (1280 + 64 * (j))
#define XB_XGEN(j)  (2304 + 64 * (j))
#define XB_TOP      3328
#define XB_TOPGEN   3392
#define XCD_BAR_WORDS 3456
#define XB_SPIN_CAP (1u << 18)

__device__ __forceinline__ unsigned xb_ld(unsigned* p)              { return __hip_atomic_load(p, __ATOMIC_RELAXED, __HIP_MEMORY_SCOPE_AGENT); }
__device__ __forceinline__ unsigned xb_add(unsigned* p, unsigned v) { return __hip_atomic_fetch_add(p, v, __ATOMIC_RELAXED, __HIP_MEMORY_SCOPE_AGENT); }
__device__ __forceinline__ unsigned xb_xcc_id() { return (unsigned)__builtin_amdgcn_s_getreg((3 << 11) | 20) & 0xFu; }
#define XB_SPIN(cond, bar) do { unsigned _sp = 0; while (cond) { __builtin_amdgcn_s_sleep(1); \
    if ((++_sp & 255u) == 0u) { if (xb_ld(&(bar)[XB_TMO])) break; if (_sp > XB_SPIN_CAP) { atomicAdd(&(bar)[XB_TMO], 1u); break; } } } } while (0)

struct XcdBarrier {
    unsigned* bar; unsigned x;
    volatile LAS unsigned* st;
};

__device__ __forceinline__ XcdBarrier xcd_barrier_post(unsigned* bar, volatile LAS unsigned* st) {
    XcdBarrier b; b.bar = bar; b.x = xb_xcc_id(); b.st = st;
    if (threadIdx.x == 0) (void)xb_add(&bar[XB_XCNT(b.x)], 1u);
    return b;
}
__device__ __forceinline__ void xcd_barrier_complete(unsigned* bar, unsigned x, unsigned& nloc, unsigned& nx) {
    const unsigned G = gridDim.x * gridDim.y * gridDim.z;
    unsigned sum, cnt, mine, sp = 0u;
    for (;;) {
        sum = 0u; cnt = 0u; mine = 0u;
#pragma unroll
        for (unsigned j = 0; j < 16; ++j) { const unsigned c = xb_ld(&bar[XB_XCNT(j)]); sum += c; cnt += (c > 0u) ? 1u : 0u; mine = (j == x) ? c : mine; }
        if (sum == G) break;
        __builtin_amdgcn_s_sleep(1);
        if ((++sp & 255u) == 0u) { if (xb_ld(&bar[XB_TMO])) break; if (sp > XB_SPIN_CAP) { atomicAdd(&bar[XB_TMO], 1u); break; } }
    }
    nloc = mine > 0u ? mine : 1u; nx = cnt > 0u ? cnt : 1u;
}

__device__ __forceinline__ void xcd_barrier(const XcdBarrier& b) {
    asm volatile("s_waitcnt vmcnt(0)" ::: "memory");
    __syncthreads();
    if (threadIdx.x == 0) {
        unsigned* bar = b.bar;
        __builtin_amdgcn_s_waitcnt(0);
        unsigned nloc = b.st[0], nx = b.st[1];
        if (nloc == 0u) { xcd_barrier_complete(bar, b.x, nloc, nx); b.st[0] = nloc; b.st[1] = nx; }
        const unsigned old = xb_add(&bar[XB_XSUB(b.x)], 1u);
        const unsigned gen = old / nloc;
        if (old + 1u == (gen + 1u) * nloc) {
            __builtin_amdgcn_fence(__ATOMIC_RELEASE, "agent");
            asm volatile("s_waitcnt vmcnt(0)" ::: "memory");
            const unsigned og = xb_add(&bar[XB_TOP], 1u);
            const unsigned tg = og / nx;
            if (og + 1u == (tg + 1u) * nx) xb_add(&bar[XB_TOPGEN], 1u);
            else XB_SPIN(xb_ld(&bar[XB_TOPGEN]) == tg, bar);
            __builtin_amdgcn_fence(__ATOMIC_ACQUIRE, "agent");
            xb_add(&bar[XB_XGEN(b.x)], 1u);
            asm volatile("s_waitcnt vmcnt(0)" ::: "memory");
        } else {
            XB_SPIN(xb_ld(&bar[XB_XGEN(b.x)]) == gen, bar);
            __builtin_amdgcn_fence(__ATOMIC_ACQUIRE, "agent");
            asm volatile("s_waitcnt vmcnt(0)" ::: "memory");
        }
    }
    __syncthreads();
}

constexpr int NWAVES = 8;
#ifndef MK_N_LAUNCHES
#define MK_N_LAUNCHES 1
#endif
constexpr int N_PHASES = 8;
constexpr int BATCH = 8, SEQ = 2048, D = 1024, M = BATCH * SEQ;
constexpr int CC = 512, CW = 31, DFF = 2816, NIN = 4296, NU = 4352;
constexpr float QSC = 0.125f * 1.4426950408889634f;
constexpr size_t MiB = 1u << 20;
constexpr size_t WS_CTL = 0, CTL_ZERO_BYTES = 1 * MiB;
constexpr size_t WS_WIN = 1 * MiB, WS_WCO = 10 * MiB, WS_WAO = 11 * MiB, WS_WOUT = 12 * MiB, WS_WGU = 14 * MiB, WS_WD = 25 * MiB, WS_SS = 31 * MiB;
constexpr size_t WS_R2 = 32 * MiB;
constexpr size_t WS_G = 64 * MiB;
constexpr size_t WS_GLU = 128 * MiB, WS_Q = 144 * MiB, WS_QI = 160 * MiB, WS_C = 176 * MiB, WS_A = 192 * MiB;
constexpr size_t WS_K = 208 * MiB, WS_V = 210 * MiB, WS_KI = 212 * MiB, WS_WI = 214 * MiB;
constexpr size_t WS_MG = 216 * MiB;
constexpr size_t WS_HFF = 64 * MiB;
constexpr size_t WS_END = 256 * MiB;
static_assert(WS_WIN + (size_t)NU * D * 2 <= WS_WCO && WS_WGU + (size_t)2 * DFF * D * 2 <= WS_WD && WS_WD + (size_t)D * DFF * 2 <= WS_SS && WS_SS + (size_t)M * 16 * 4 <= WS_R2, "weights map");
static_assert(WS_HFF + (size_t)M * DFF * 2 <= WS_QI && WS_MG + (size_t)M * D * 2 <= WS_END && WS_WI + (size_t)M * 8 * 4 <= WS_MG, "activation map");
constexpr int CW_BAR = 4096;
constexpr int RING_OFF = 0, RING_BYTES = 131072;
constexpr int LDSCTL_OFF = RING_BYTES, MISC_OFF = LDSCTL_OFF + 320;
constexpr int LDS_BYTES = 147456;

struct Frame {
    LAS unsigned char* lds; volatile LAS unsigned* MISC; gu32* ctl;
    int tid, lane, wave, vcu, G;
};
__device__ __forceinline__ float wave_sum(float v) {
#pragma unroll
    for (int o = 1; o < 64; o <<= 1) v += __shfl_xor(v, o);
    return v;
}
__device__ __forceinline__ float bf2f(bf16 h) { return __uint_as_float((unsigned)h << 16); }
__device__ __forceinline__ float bflo(unsigned w) { return __uint_as_float(w << 16); }
__device__ __forceinline__ float bfhi(unsigned w) { return __uint_as_float(w & 0xffff0000u); }
__device__ __forceinline__ float sigmoidf_(float x) { return __builtin_amdgcn_rcpf(1.0f + __expf(-x)); }

template <class MapF>
__device__ __forceinline__ void p0_transpose_item(const float* W, int K, int N, bf16* WT, LAS float* scr, int item, int lane, const float* kscale, MapF dst) {
    const int nblk = (N + 31) / 32, kb = item / nblk, nb = item % nblk, k0 = 64 * kb, n0 = 32 * nb;
    const int nl = n0 + (lane & 31);
#pragma unroll 8
    for (int i = 0; i < 32; ++i) { const int kk = 2 * i + (lane >> 5); float v = (nl < N) ? W[(size_t)(k0 + kk) * N + nl] : 0.f; if (kscale) v *= kscale[k0 + kk]; scr[kk * 33 + (lane & 31)] = v; }
    LDS_WAIT(); asm volatile("" ::: "memory");
    const int c = lane & 7;
#pragma unroll
    for (int j = 0; j < 4; ++j) { const int n = (lane >> 3) + 8 * j; const LAS float* s = scr + (8 * c) * 33 + n;
        v4u o; o.x = pk2(s[0 * 33], s[1 * 33]); o.y = pk2(s[2 * 33], s[3 * 33]); o.z = pk2(s[4 * 33], s[5 * 33]); o.w = pk2(s[6 * 33], s[7 * 33]);
        if (n0 + n < N) *(GAS v4u*)(WT + (size_t)dst(n0 + n) * K + k0 + 8 * c) = o; }
    LDS_WAIT(); asm volatile("" ::: "memory");
}
struct MapId { __device__ __forceinline__ int operator()(int n) const { return n; } };
struct MapWin {
    __device__ __forceinline__ int operator()(int n) const {
        if (n < 512) return 256 * (n >> 7) + (n & 127);
        if (n < 1024) { const int c = n - 512; return 256 * (c >> 7) + 128 + (c & 127); }
        if (n < 1536) return n;
        if (n < 1600) return 2048 + (n - 1536);
        if (n < 1664) return 2048 + 64 + (n - 1600);
        if (n < 2176) return 1536 + (n - 1664);
        if (n < 2240) return 2048 + 128 + (n - 2176);
        if (n < 2248) return 2048 + 192 + (n - 2240);
        return 2304 + (n - 2248);
    }
};
struct MapGU { int up; __device__ __forceinline__ int operator()(int n) const { return 256 * (n >> 7) + 128 * up + (n & 127); } };

__device__ __forceinline__ void rms_row_to_bf16(int lane, const float* xrow, const float* g, bf16* orow) {
    const GAS f32x4* xr = (const GAS f32x4*)xrow + lane; f32x4 v[4]; float s = 0.f;
#pragma unroll
    for (int j = 0; j < 4; ++j) { v[j] = xr[64 * j]; s += (v[j].x * v[j].x + v[j].y * v[j].y) + (v[j].z * v[j].z + v[j].w * v[j].w); }
    const float rstd = 1.f / sqrtf(wave_sum(s) * (1.f / D) + 1e-6f);
    GAS unsigned long long* o8 = (GAS unsigned long long*)orow + lane;
#pragma unroll
    for (int j = 0; j < 4; ++j) { const f32x4 gv = ((const GAS f32x4*)g)[lane + 64 * j];
        o8[64 * j] = (unsigned long long)pk2(v[j].x * rstd * gv.x, v[j].y * rstd * gv.y) | ((unsigned long long)pk2(v[j].z * rstd * gv.z, v[j].w * rstd * gv.w) << 32); }
}
struct Args { const float* in[16]; float* out; unsigned char* ws; int ph_lo, ph_hi; };

__device__ __forceinline__ void p0_prologue(Frame& F, const Args& a) {
    LAS float* scr = (LAS float*)(F.lds + RING_OFF + F.wave * 16384);
    const int gw = F.vcu * NWAVES + F.wave, NGW = F.G * NWAVES;
    unsigned char* ws = a.ws;
    constexpr int I_IN = (D / 64) * ((NIN + 31) / 32), I_CO = (CC / 64) * (D / 32), I_OUT = (D / 64) * (D / 32), I_G = (D / 64) * (DFF / 32), I_D = (DFF / 64) * (D / 32);
    constexpr int NITEMS = I_IN + 2 * I_CO + I_OUT + 2 * I_G + I_D;
    for (int it = gw; it < NITEMS; it += NGW) {
        int r = it;
        if (r < I_IN) { p0_transpose_item(a.in[2], D, NIN, (bf16*)(ws + WS_WIN), scr, r, F.lane, nullptr, MapWin{}); continue; } r -= I_IN;
        if (r < I_CO) { p0_transpose_item(a.in[8], CC, D, (bf16*)(ws + WS_WCO), scr, r, F.lane, nullptr, MapId{}); continue; } r -= I_CO;
        if (r < I_CO) { p0_transpose_item(a.in[9], CC, D, (bf16*)(ws + WS_WAO), scr, r, F.lane, nullptr, MapId{}); continue; } r -= I_CO;
        if (r < I_OUT) { p0_transpose_item(a.in[10], D, D, (bf16*)(ws + WS_WOUT), scr, r, F.lane, nullptr, MapId{}); continue; } r -= I_OUT;
        if (r < I_G) { p0_transpose_item(a.in[12], D, DFF, (bf16*)(ws + WS_WGU), scr, r, F.lane, a.in[11], MapGU{0}); continue; } r -= I_G;
        if (r < I_G) { p0_transpose_item(a.in[13], D, DFF, (bf16*)(ws + WS_WGU), scr, r, F.lane, a.in[11], MapGU{1}); continue; } r -= I_G;
        p0_transpose_item(a.in[14], DFF, D, (bf16*)(ws + WS_WD), scr, r, F.lane, nullptr, MapId{});
    }
    for (int m = gw; m < M; m += NGW) rms_row_to_bf16(F.lane, a.in[0] + (size_t)m * D, a.in[1], (bf16*)(ws + WS_R2) + (size_t)m * D);
}

__device__ __forceinline__ void conv_phase(Frame& F, const Args& a) {
    const float* conv_w = a.in[4]; const float* conv_b = a.in[5]; const float* ln_g = a.in[6]; const float* ln_b = a.in[7];
    const bf16* GLU = (const bf16*)(a.ws + WS_GLU); bf16* C = (bf16*)(a.ws + WS_C);
    LAS float* Wl = (LAS float*)(F.lds + RING_OFF);
    LAS float* Pl = (LAS float*)(F.lds + RING_OFF + 65536);
    for (int i = F.tid; i < CW * CC; i += NWAVES * 64) Wl[i] = conv_w[i];
    __syncthreads();
    const int g = F.wave >> 2, cw = F.wave & 3, ch = 128 * cw + 2 * F.lane;
    const float cb0 = conv_b[ch], cb1 = conv_b[ch + 1], lg0 = ln_g[ch], lg1 = ln_g[ch + 1], lb0 = ln_b[ch], lb1 = ln_b[ch + 1];
    for (int unit = F.vcu; unit < M / 32; unit += F.G) {
        const int m0 = unit * 32 + 16 * g, t0 = m0 % SEQ;
        float x0[46], x1[46];
#pragma unroll
        for (int r = 0; r < 46; ++r) { const int t = t0 - 30 + r; const unsigned w = (t >= 0) ? *(const GAS unsigned*)(GLU + (size_t)(m0 - 30 + r) * CC + ch) : 0u; x0[r] = bflo(w); x1[r] = bfhi(w); }
        float a0[16], a1[16];
#pragma unroll
        for (int tt = 0; tt < 16; ++tt) { a0[tt] = cb0; a1[tt] = cb1; }
#pragma unroll
        for (int j = 0; j < CW; ++j) { const float w0 = Wl[j * CC + ch], w1 = Wl[j * CC + ch + 1];
#pragma unroll
            for (int tt = 0; tt < 16; ++tt) { a0[tt] += w0 * x0[tt + j]; a1[tt] += w1 * x1[tt + j]; } }
#pragma unroll
        for (int tt = 0; tt < 16; ++tt) { const float s1 = wave_sum(a0[tt] + a1[tt]), s2 = wave_sum(a0[tt] * a0[tt] + a1[tt] * a1[tt]);
            if (F.lane == 0) { Pl[((g * 16 + tt) * 4 + cw) * 2] = s1; Pl[((g * 16 + tt) * 4 + cw) * 2 + 1] = s2; } }
        __syncthreads();
#pragma unroll
        for (int tt = 0; tt < 16; ++tt) { const LAS float* p = Pl + (g * 16 + tt) * 8;
            const float s1 = (p[0] + p[2]) + (p[4] + p[6]), s2 = (p[1] + p[3]) + (p[5] + p[7]);
            const float mu = s1 * (1.f / CC), var = s2 * (1.f / CC) - mu * mu, rstd = 1.f / sqrtf(fmaxf(var, 0.f) + 1e-5f);
            const float z0 = (a0[tt] - mu) * rstd * lg0 + lb0, z1 = (a1[tt] - mu) * rstd * lg1 + lb1;
            *(GAS unsigned*)(C + (size_t)(m0 + tt) * CC + ch) = pk2(z0 * sigmoidf_(z0), z1 * sigmoidf_(z1)); }
        __syncthreads();
    }
}

__device__ __forceinline__ unsigned fkey(float f) { f += 0.0f; const unsigned u = __float_as_uint(f); return (u & 0x80000000u) ? ~u : (u | 0x80000000u); }
__device__ __forceinline__ void attn_simple(Frame& F, const Args& a) {
    const bf16* Q = (const bf16*)(a.ws + WS_Q); const bf16* QI = (const bf16*)(a.ws + WS_QI); const bf16* Kb = (const bf16*)(a.ws + WS_K); const bf16* Vb = (const bf16*)(a.ws + WS_V);
    const bf16* KI = (const bf16*)(a.ws + WS_KI); const float* WI = (const float*)(a.ws + WS_WI); bf16* A = (bf16*)(a.ws + WS_A);
    LAS unsigned* keys = (LAS unsigned*)(F.lds + RING_OFF);
    LAS float* qs = (LAS float*)(F.lds + RING_OFF + 8192);
    LAS float* att = (LAS float*)(F.lds + RING_OFF + 10240);
    LAS int* sel = (LAS int*)(F.lds + RING_OFF + 18432);
    LAS float* sm = (LAS float*)(F.lds + RING_OFF + 19456);
    LAS unsigned* cnt = (LAS unsigned*)(F.lds + RING_OFF + 19584);
    const int tid = F.tid, NT = NWAVES * 64;
    for (int qi = 0;; ++qi) {
        const int m = qi * F.G + F.vcu; if (m >= M) break;
        const int b = m / SEQ, t = m % SEQ;
        for (int i = tid; i < 512; i += NT) qs[i] = bf2f(QI[(size_t)m * 512 + i]);
        if (tid < 8) sm[tid] = WI[(size_t)m * 8 + tid];
        __syncthreads();
        for (int s = tid; s < SEQ; s += NT) {
            unsigned key = 0u;
            if (s <= t) {
                const bf16* kr = KI + ((size_t)b * SEQ + s) * 64; float kv[64];
#pragma unroll
                for (int e = 0; e < 64; ++e) kv[e] = bf2f(kr[e]);
                float sc = 0.f;
                for (int h = 0; h < 8; ++h) { float d = 0.f;
#pragma unroll
                    for (int e = 0; e < 64; ++e) d += qs[h * 64 + e] * kv[e];
                    sc += sm[h] * fmaxf(d, 0.f); }
                key = fkey(sc);
            }
            keys[s] = key;
        }
        __syncthreads();
        const int nsel = (t + 1 < 256) ? (t + 1) : 256;
        if (t + 1 <= 256) { for (int s = tid; s <= t; s += NT) sel[s] = s; }
        else {
            unsigned T = 0u;
            for (int bit = 31; bit >= 0; --bit) {
                const unsigned cand = T | (1u << bit);
                if (tid == 0) cnt[0] = 0u;
                __syncthreads();
                unsigned c = 0;
#pragma unroll
                for (int i = 0; i < SEQ / (NWAVES * 64); ++i) c += (keys[tid + i * NT] >= cand) ? 1u : 0u;
#pragma unroll
                for (int o = 1; o < 64; o <<= 1) c += __shfl_xor(c, o);
                if (F.lane == 0 && c) atomicAdd((unsigned*)cnt, c);
                __syncthreads();
                if (cnt[0] >= 256u) T = cand;
                __syncthreads();
            }
            if (F.wave == 0) {
                int base = 0;
                for (int s0 = 0; s0 <= t; s0 += 64) { const int s = s0 + F.lane; const bool p = (s <= t) && (keys[s] > T);
                    const unsigned long long bm = __ballot(p); const int pos = base + __builtin_amdgcn_mbcnt_hi((unsigned)(bm >> 32), __builtin_amdgcn_mbcnt_lo((unsigned)bm, 0u));
                    if (p) sel[pos] = s; base += __builtin_popcountll(bm); }
                for (int s0 = 0; s0 <= t && base < 256; s0 += 64) { const int s = s0 + F.lane; const bool p = (s <= t) && (keys[s] == T);
                    const unsigned long long bm = __ballot(p); const int pos = base + __builtin_amdgcn_mbcnt_hi((unsigned)(bm >> 32), __builtin_amdgcn_mbcnt_lo((unsigned)bm, 0u));
                    if (p && pos < 256) sel[pos] = s; base += __builtin_popcountll(bm); }
            }
        }
        for (int i = tid; i < 512; i += NT) qs[i] = bf2f(Q[(size_t)m * 512 + i]);
        __syncthreads();
        for (int idx = tid; idx < 8 * 256; idx += NT) { const int h = idx >> 8, k = idx & 255;
            if (k < nsel) { const int s = sel[k]; const bf16* kr = Kb + ((size_t)b * SEQ + s) * 64; float d = 0.f;
#pragma unroll
                for (int e = 0; e < 64; ++e) d += qs[h * 64 + e] * bf2f(kr[e]);
                att[h * 256 + k] = d - exp2f(-(float)(h + 1)) * 1.4426950408889634f * (float)(t - s); } }
        __syncthreads();
        if (tid < 8) { float mx = -INFINITY; for (int k = 0; k < nsel; ++k) mx = fmaxf(mx, att[tid * 256 + k]); float l = 0.f; for (int k = 0; k < nsel; ++k) l += exp2f(att[tid * 256 + k] - mx); sm[8 + tid] = mx; sm[16 + tid] = l; }
        __syncthreads();
        for (int idx = tid; idx < 8 * 256; idx += NT) { const int h = idx >> 8, k = idx & 255; att[idx] = (k < nsel) ? exp2f(att[idx] - sm[8 + h]) / sm[16 + h] : 0.f; }
        __syncthreads();
        { const int h = tid >> 6, d = tid & 63; float o = 0.f;
            for (int k = 0; k < nsel; ++k) o += att[h * 256 + k] * bf2f(Vb[((size_t)b * SEQ + sel[k]) * 64 + d]);
            A[(size_t)m * 512 + tid] = (bf16)f2bf(o); }
        __syncthreads();
    }
}

__device__ __forceinline__ void final_norm(Frame& F, const Args& a) {
    const float* SS = (const float*)(a.ws + WS_SS); const float* g = a.in[15]; float* out = a.out;
    const int gw = F.vcu * NWAVES + F.wave, NGW = F.G * NWAVES;
    for (int m = gw; m < M; m += NGW) {
        const f32x4 s0 = *(const f32x4*)(SS + (size_t)m * 16), s1 = *(const f32x4*)(SS + (size_t)m * 16 + 4), s2 = *(const f32x4*)(SS + (size_t)m * 16 + 8), s3 = *(const f32x4*)(SS + (size_t)m * 16 + 12);
        const f32x4 st = (s0 + s1) + (s2 + s3); const float rstd = 1.f / sqrtf(((st[0] + st[1]) + (st[2] + st[3])) * (1.f / D) + 1e-6f);
        GAS f32x4* o = (GAS f32x4*)(out + (size_t)m * D) + F.lane;
#pragma unroll
        for (int j = 0; j < 4; ++j) { const f32x4 gv = ((const GAS f32x4*)g)[F.lane + 64 * j]; o[64 * j] = o[64 * j] * rstd * gv; }
    }
}

__global__ void __launch_bounds__(NWAVES * 64, 2) mk_fwd(Args args) {
    extern __shared__ __attribute__((aligned(16))) unsigned char lds[];
    Frame F;
    F.lds = (LAS unsigned char*)lds; F.MISC = (volatile LAS unsigned*)(F.lds + MISC_OFF);
    F.tid = threadIdx.x; F.lane = F.tid & 63; F.wave = __builtin_amdgcn_readfirstlane(F.tid >> 6);
    F.G = gridDim.x; { const int bx = blockIdx.x; F.vcu = (F.G % 8 == 0) ? (bx % 8) * (F.G / 8) + bx / 8 : bx; }
    unsigned char* ws = args.ws;
    F.ctl = (gu32*)(ws + WS_CTL);
    for (int u = F.tid; u < (LDS_BYTES - LDSCTL_OFF) / 4; u += NWAVES * 64) ((LAS unsigned*)(F.lds + LDSCTL_OFF))[u] = 0u;
    __syncthreads();
    XcdBarrier bar; bar.bar = (unsigned*)(F.ctl + CW_BAR); bar.x = 0; bar.st = nullptr;
    if (MK_N_LAUNCHES == 1) bar = xcd_barrier_post((unsigned*)(F.ctl + CW_BAR), F.MISC + 8);
    const int lo = args.ph_lo, hi = args.ph_hi;
#define IN(k) (lo <= (k) && (k) < hi)
#define GRID_BAR(k) do { if (IN(k) && IN((k) + 1)) xcd_barrier(bar); } while (0)
    bf16* R2 = (bf16*)(ws + WS_R2); bf16* Gt = (bf16*)(ws + WS_G); bf16* MG = (bf16*)(ws + WS_MG); float* SS = (float*)(ws + WS_SS);
    if (IN(0)) { p0_prologue(F, args); GRID_BAR(0); }
    if (IN(1)) {
        pg8::Gemm g{R2, (const bf16*)(ws + WS_WIN), M, NU, D}; pg8::StaticOrder S; S.init(M, NU, F.G, (int)blockIdx.x);
        pg8::EpiU E{(bf16*)(ws + WS_GLU), (bf16*)(ws + WS_Q), (bf16*)(ws + WS_QI), (bf16*)(ws + WS_K), (bf16*)(ws + WS_V), (bf16*)(ws + WS_KI), Gt, (float*)(ws + WS_WI), args.in[3], QSC};
        pg8::gemm_phase<pg8::EpiU, pg8::StaticOrder, false, true>(F.lds + RING_OFF, g, S, E);
        GRID_BAR(1);
    }
    if (IN(2)) { conv_phase(F, args); attn_simple(F, args); GRID_BAR(2); }
    if (IN(3)) {
        { pg8::Gemm g{(const bf16*)(ws + WS_C), (const bf16*)(ws + WS_WCO), M, D, CC}; pg8::StaticOrder S; S.init(M, D, F.G, (int)blockIdx.x);
          pg8::EpiMix<false> E{Gt, R2, MG}; pg8::gemm_phase<pg8::EpiMix<false>, pg8::StaticOrder, false, true>(F.lds + RING_OFF, g, S, E); }
        { pg8::Gemm g{(const bf16*)(ws + WS_A), (const bf16*)(ws + WS_WAO), M, D, CC}; pg8::StaticOrder S; S.init(M, D, F.G, (int)blockIdx.x);
          pg8::EpiMix<true> E{Gt, R2, MG}; pg8::gemm_phase<pg8::EpiMix<true>, pg8::StaticOrder, false, true>(F.lds + RING_OFF, g, S, E); }
        GRID_BAR(3);
    }
    if (IN(4)) {
        pg8::Gemm g{MG, (const bf16*)(ws + WS_WOUT), M, D, D}; pg8::StaticOrder S; S.init(M, D, F.G, (int)blockIdx.x);
        pg8::EpiRes<true> E{args.in[0], args.out, R2, SS}; pg8::gemm_phase<pg8::EpiRes<true>, pg8::StaticOrder, false, true>(F.lds + RING_OFF, g, S, E);
        GRID_BAR(4);
    }
    if (IN(5)) {
        pg8::Gemm g{R2, (const bf16*)(ws + WS_WGU), M, 2 * DFF, D}; pg8::StaticOrder S; S.init(M, 2 * DFF, F.G, (int)blockIdx.x);
        pg8::EpiFF E{(bf16*)(ws + WS_HFF), SS, DFF}; pg8::gemm_phase<pg8::EpiFF, pg8::StaticOrder, false, true>(F.lds + RING_OFF, g, S, E);
        GRID_BAR(5);
    }
    if (IN(6)) {
        pg8::Gemm g{(const bf16*)(ws + WS_HFF), (const bf16*)(ws + WS_WD), M, D, DFF}; pg8::StaticOrder S; S.init(M, D, F.G, (int)blockIdx.x);
        pg8::EpiRes<false> E{args.out, args.out, nullptr, SS}; pg8::gemm_phase<pg8::EpiRes<false>, pg8::StaticOrder, false, true>(F.lds + RING_OFF, g, S, E);
        GRID_BAR(6);
    }
    if (IN(7)) final_norm(F, args);
#undef IN
#undef GRID_BAR
}


#ifndef MK_DIGEST
#define MK_DIGEST 0
#endif
__global__ void digest_k(const unsigned char* ws, float* out, int which) {
    const size_t i = (size_t)blockIdx.x * blockDim.x + threadIdx.x; if (i >= (size_t)M * D) return;
    const size_t m = i / D; const int c = (int)(i % D); float v = 0.f;
    if (which == 1) {
        const bf16* G = (const bf16*)(ws + WS_G); v += bf2f(G[m * 2048 + c]) + 2.f * bf2f(G[m * 2048 + 1024 + c]);
        v += 3.f * bf2f(((const bf16*)(ws + WS_GLU))[m * 512 + (c & 511)]) + 5.f * bf2f(((const bf16*)(ws + WS_Q))[m * 512 + (c & 511)]) + 7.f * bf2f(((const bf16*)(ws + WS_QI))[m * 512 + (c & 511)]);
        v += 11.f * bf2f(((const bf16*)(ws + WS_K))[m * 64 + (c & 63)]) + 13.f * bf2f(((const bf16*)(ws + WS_V))[m * 64 + (c & 63)]) + 17.f * bf2f(((const bf16*)(ws + WS_KI))[m * 64 + (c & 63)]) + 19.f * ((const float*)(ws + WS_WI))[m * 8 + (c & 7)];
    } else if (which == 2) {
        v = (c < 512) ? bf2f(((const bf16*)(ws + WS_C))[m * 512 + c]) : bf2f(((const bf16*)(ws + WS_A))[m * 512 + c - 512]);
    } else if (which == 3) {
        v = bf2f(((const bf16*)(ws + WS_MG))[m * 1024 + c]);
    } else if (which == 0) {
        v = bf2f(((const bf16*)(ws + WS_R2))[m * 1024 + c]) + bf2f(((const bf16*)(ws + WS_WIN))[(m % 4352) * 1024 + c]) + bf2f(((const bf16*)(ws + WS_WGU))[(m % 5632) * 1024 + c]) + bf2f(((const bf16*)(ws + WS_WD))[(size_t)(m % 1024) * 2816 + c]);
    }
    out[i] = v;
}

extern "C" void kernel_launch(void* const* d_in, const int* in_sizes, int n_in, void* d_out, int out_size, void* d_ws, size_t ws_size, hipStream_t stream) {
    static int grid = 0;
    if (grid == 0) {
        if (n_in != 16 || in_sizes[0] != M * D || out_size != M * D || ws_size < WS_END) { fprintf(stderr, "kernel_launch: unexpected problem shape (n_in %d, in0 %d, out %d, ws %zu)\n", n_in, n_in > 0 ? in_sizes[0] : -1, out_size, ws_size); grid = -1; return; }
        int dev = 0, cus = 0, per_cu = 0;
        if (hipGetDevice(&dev) != hipSuccess || hipDeviceGetAttribute(&cus, hipDeviceAttributeMultiprocessorCount, dev) != hipSuccess) { grid = -1; return; }
        if (hipFuncSetAttribute((const void*)mk_fwd, hipFuncAttributeMaxDynamicSharedMemorySize, LDS_BYTES) != hipSuccess) { fprintf(stderr, "kernel_launch: hipFuncSetAttribute failed\n"); grid = -1; return; }
        if (hipOccupancyMaxActiveBlocksPerMultiprocessor(&per_cu, (const void*)mk_fwd, NWAVES * 64, LDS_BYTES) != hipSuccess || per_cu < 1) { fprintf(stderr, "kernel_launch: occupancy query says %d blocks per CU\n", per_cu); per_cu = 1; }
        (void)hipGetLastError();
        grid = cus;
    }
    if (grid < 0) return;
    if (hipMemsetAsync((char*)d_ws + WS_CTL, 0, CTL_ZERO_BYTES, stream) != hipSuccess) return;
    Args a{};
    for (int i = 0; i < 16; ++i) a.in[i] = (const float*)d_in[i];
    a.out = (float*)d_out; a.ws = (unsigned char*)d_ws;
    if (MK_N_LAUNCHES == 1) { a.ph_lo = 0; a.ph_hi = N_PHASES; hipLaunchKernelGGL(mk_fwd, dim3(grid), dim3(NWAVES * 64), LDS_BYTES, stream, a); }
    else for (int p = 0; p < (MK_DIGEST ? MK_DIGEST : N_PHASES); ++p) { a.ph_lo = p; a.ph_hi = p + 1; hipLaunchKernelGGL(mk_fwd, dim3(grid), dim3(NWAVES * 64), LDS_BYTES, stream, a); }
    if (MK_DIGEST) hipLaunchKernelGGL(digest_k, dim3((unsigned)(((size_t)M * D + 255) / 256)), dim3(256), 0, stream, (const unsigned char*)d_ws, (float*)d_out, MK_DIGEST - 1);
    const hipError_t le = hipPeekAtLastError();
    if (le != hipSuccess) fprintf(stderr, "kernel_launch: launch failed: %s\n", hipGetErrorName(le));
}
```

```cpp
#include <hip/hip_runtime.h>
#include <cstdio>
#include <cstdint>
#include <cmath>
namespace pg8 {
#define PG8_LAS __attribute__((address_space(3)))
typedef unsigned short bf16_t;
typedef short bf16x8 __attribute__((ext_vector_type(8)));
typedef float f32x4 __attribute__((ext_vector_type(4)));
typedef unsigned u32x4 __attribute__((ext_vector_type(4)));
constexpr int BM = 256, BK = 64, HALF = 128, HTB = HALF * BK * 2  , STAGE_BYTES = 8 * HTB, NXCD = 8, WGM = 8;

__host__ __device__ __forceinline__ int lds_byte(int r, int c) { const int st = (r >> 4) * 2 + (c >> 5), rr = r & 15, cc = c & 31, ob = rr * 64 + cc * 2; return st * 1024 + (ob ^ (((ob >> 9) & 1) << 5)); }
__host__ __device__ __forceinline__ void stage_rc(int b, int& R, int& C) { const int st = b / 1024, sb = b % 1024, swz = sb ^ (((sb >> 9) & 1) << 5); R = (st >> 1) * 16 + swz / 64; C = (st & 1) * 32 + (swz % 64) / 2; }
__host__ __device__ __forceinline__ int perm32(int rho) { const int n = rho >> 4, i = rho & 15; return 8 * (i >> 2) + 4 * n + (i & 3); }

struct Unit { int pm, pn; };
struct Gemm { const bf16_t* A; const bf16_t* Bt; int M, N, K; };

struct StaticOrder {
    int nM, nN, nwg, G, c;
    __host__ __device__ void init(int M, int N, int G_, int c_) { nM = M / BM; nN = N / BM; nwg = nM * nN; G = G_; c = c_; }
    __host__ __device__ bool next(int i, Unit& u) const {
        const long L = (long)i * G + c; if (L >= nwg) return false;
        int wgid = (int)L; { const int q = nwg / NXCD, r = nwg % NXCD, xcd = wgid % NXCD, off = wgid / NXCD; wgid = (xcd < r ? xcd * (q + 1) : r * (q + 1) + (xcd - r) * q) + off; }
        const int nig = WGM * nN, gid = wgid / nig, fm = gid * WGM, gsz = (nM - fm) < WGM ? (nM - fm) : WGM;
        u.pm = fm + ((wgid % nig) % gsz); u.pn = (wgid % nig) / gsz; return true;
    }
    __device__ __forceinline__ void a_ready(const Unit&) const {}
    __device__ __forceinline__ void done(const Unit&) const {}
};

typedef float f32x2cv __attribute__((ext_vector_type(2)));
typedef __bf16 bf16x2cv __attribute__((ext_vector_type(2)));
__device__ __forceinline__ unsigned cvt_pk_bf16(float lo, float hi) { const f32x2cv v = {lo, hi}; const bf16x2cv b = __builtin_convertvector(v, bf16x2cv); return __builtin_bit_cast(unsigned, b); }
typedef float f32x2 __attribute__((ext_vector_type(2)));
__device__ __forceinline__ float bf_lo(unsigned w) { return __uint_as_float(w << 16); }
__device__ __forceinline__ float bf_hi(unsigned w) { return __uint_as_float(w & 0xffff0000u); }
__device__ __forceinline__ float fsigmoid(float x) { return __builtin_amdgcn_rcpf(1.0f + __expf(-x)); }
__device__ __forceinline__ u32x4 pack8(const f32x4 a, const f32x4 b) { u32x4 w; w.x = cvt_pk_bf16(a[0], a[1]); w.y = cvt_pk_bf16(a[2], a[3]); w.z = cvt_pk_bf16(b[0], b[1]); w.w = cvt_pk_bf16(b[2], b[3]); return w; }
__device__ __forceinline__ void unpack8(const u32x4 w, f32x4& a, f32x4& b) { a = (f32x4){bf_lo(w.x), bf_hi(w.x), bf_lo(w.y), bf_hi(w.y)}; b = (f32x4){bf_lo(w.z), bf_hi(w.z), bf_lo(w.w), bf_hi(w.w)}; }
__device__ __forceinline__ f32x4 sig4(const f32x4 v) { return (f32x4){fsigmoid(v[0]), fsigmoid(v[1]), fsigmoid(v[2]), fsigmoid(v[3])}; }

struct EpiU {
    static constexpr bool PERM = true, AFTER_DRAIN = false;
    bf16_t *GLU, *Q, *QI, *Kb, *Vb, *KI, *G; float* WI; const float* bgate; float qsc;
    __device__ __forceinline__ void operator()(const f32x4 (&acc)[2][2][4][2], const Unit& u, int wr, int wc, int fr, int fq) const {
        const int pn = u.pn, row0 = u.pm * BM + wr * 64 + fr, cl = wc * 32 + 8 * fq;
        if (pn < 4) {
#pragma unroll
            for (int ai = 0; ai < 2; ++ai)
#pragma unroll
                for (int m = 0; m < 4; ++m) { const size_t row = (size_t)(row0 + ai * HALF + m * 16);
                    const f32x4 r0 = acc[ai][0][m][0] * sig4(acc[ai][1][m][0]), r1 = acc[ai][0][m][1] * sig4(acc[ai][1][m][1]);
                    *(u32x4*)(GLU + row * 512 + pn * 128 + cl) = pack8(r0, r1); }
        } else if (pn < 8) {
            bf16_t* base = (pn < 6) ? Q : QI; const float sc = (pn < 6) ? qsc : 0.125f; const int c0 = ((pn - 4) & 1) * 256 + cl;
#pragma unroll
            for (int ai = 0; ai < 2; ++ai)
#pragma unroll
                for (int m = 0; m < 4; ++m) { const size_t row = (size_t)(row0 + ai * HALF + m * 16);
#pragma unroll
                    for (int bj = 0; bj < 2; ++bj) *(u32x4*)(base + row * 512 + c0 + bj * HALF) = pack8(acc[ai][bj][m][0] * sc, acc[ai][bj][m][1] * sc); }
        } else if (pn == 8) {
#pragma unroll
            for (int ai = 0; ai < 2; ++ai)
#pragma unroll
                for (int m = 0; m < 4; ++m) { const size_t row = (size_t)(row0 + ai * HALF + m * 16);
                    bf16_t* d0 = (wc < 2) ? (Kb + row * 64 + cl) : (Vb + row * 64 + (cl - 64));
                    *(u32x4*)d0 = pack8(acc[ai][0][m][0], acc[ai][0][m][1]);
                    if (wc < 2) *(u32x4*)(KI + row * 64 + cl) = pack8(acc[ai][1][m][0], acc[ai][1][m][1]);
                    else if (wc == 2 && fq == 0) { *(f32x4*)(WI + row * 8) = acc[ai][1][m][0] * 0.35355339059327373f; *(f32x4*)(WI + row * 8 + 4) = acc[ai][1][m][1] * 0.35355339059327373f; } }
        } else {
            const int gc = (pn - 9) * 256 + cl;
            f32x4 bv[2][2];
#pragma unroll
            for (int bj = 0; bj < 2; ++bj)
#pragma unroll
                for (int n = 0; n < 2; ++n) bv[bj][n] = *(const f32x4*)(bgate + gc + bj * HALF + 4 * n);
#pragma unroll
            for (int ai = 0; ai < 2; ++ai)
#pragma unroll
                for (int m = 0; m < 4; ++m) { const size_t row = (size_t)(row0 + ai * HALF + m * 16);
#pragma unroll
                    for (int bj = 0; bj < 2; ++bj) *(u32x4*)(G + row * 2048 + gc + bj * HALF) = pack8(sig4(acc[ai][bj][m][0] + bv[bj][0]), sig4(acc[ai][bj][m][1] + bv[bj][1])); }
        }
    }
};
template <bool SECOND> struct EpiMix {
    static constexpr bool PERM = true, AFTER_DRAIN = false;
    const bf16_t* G; bf16_t* T1; bf16_t* MG;
    __device__ __forceinline__ void operator()(const f32x4 (&acc)[2][2][4][2], const Unit& u, int wr, int wc, int fr, int fq) const {
        const int row0 = u.pm * BM + wr * 64 + fr, c0 = u.pn * BM + wc * 32 + 8 * fq;
#pragma unroll
        for (int ai = 0; ai < 2; ++ai)
#pragma unroll
            for (int m = 0; m < 4; ++m) { const size_t row = (size_t)(row0 + ai * HALF + m * 16);
#pragma unroll
                for (int bj = 0; bj < 2; ++bj) { const int c = c0 + bj * HALF;
                    f32x4 g0, g1; unpack8(*(const u32x4*)(G + row * 2048 + (SECOND ? 1024 : 0) + c), g0, g1);
                    f32x4 r0 = g0 * acc[ai][bj][m][0], r1 = g1 * acc[ai][bj][m][1];
                    if (SECOND) { f32x4 t0, t1; unpack8(*(const u32x4*)(T1 + row * 1024 + c), t0, t1); r0 += t0; r1 += t1; *(u32x4*)(MG + row * 1024 + c) = pack8(r0, r1); }
                    else *(u32x4*)(T1 + row * 1024 + c) = pack8(r0, r1); } }
    }
};
template <bool WB16> struct EpiRes {
    static constexpr bool PERM = true, AFTER_DRAIN = false;
    const float* base; float* out; bf16_t* xb; float* SS;
    __device__ __forceinline__ void operator()(const f32x4 (&acc)[2][2][4][2], const Unit& u, int wr, int wc, int fr, int fq) const {
        const int row0 = u.pm * BM + wr * 64 + fr, c0 = u.pn * BM + wc * 32 + 8 * fq;
#pragma unroll
        for (int ai = 0; ai < 2; ++ai)
#pragma unroll
            for (int m = 0; m < 4; ++m) { const size_t row = (size_t)(row0 + ai * HALF + m * 16); float s = 0.f;
#pragma unroll
                for (int bj = 0; bj < 2; ++bj) { const size_t o = row * 1024 + c0 + bj * HALF;
                    const f32x4 r0 = *(const f32x4*)(base + o) + acc[ai][bj][m][0], r1 = *(const f32x4*)(base + o + 4) + acc[ai][bj][m][1];
                    *(f32x4*)(out + o) = r0; *(f32x4*)(out + o + 4) = r1;
                    if (WB16) *(u32x4*)(xb + o) = pack8(r0, r1);
                    s += (r0[0] * r0[0] + r0[1] * r0[1]) + (r0[2] * r0[2] + r0[3] * r0[3]) + (r1[0] * r1[0] + r1[1] * r1[1]) + (r1[2] * r1[2] + r1[3] * r1[3]); }
                s += __shfl_xor(s, 16); s += __shfl_xor(s, 32);
                if (fq == 0) SS[row * 16 + u.pn * 4 + wc] = s; }
    }
};
struct EpiFF {
    static constexpr bool PERM = true, AFTER_DRAIN = false;
    bf16_t* H; const float* SS; int ldh;
    __device__ __forceinline__ void operator()(const f32x4 (&acc)[2][2][4][2], const Unit& u, int wr, int wc, int fr, int fq) const {
        const int row0 = u.pm * BM + wr * 64 + fr, cl = u.pn * 128 + wc * 32 + 8 * fq;
#pragma unroll
        for (int ai = 0; ai < 2; ++ai)
#pragma unroll
            for (int m = 0; m < 4; ++m) { const size_t row = (size_t)(row0 + ai * HALF + m * 16);
                const f32x4 s0 = *(const f32x4*)(SS + row * 16), s1 = *(const f32x4*)(SS + row * 16 + 4), s2 = *(const f32x4*)(SS + row * 16 + 8), s3 = *(const f32x4*)(SS + row * 16 + 12);
                const f32x4 st = (s0 + s1) + (s2 + s3); const float ss = (st[0] + st[1]) + (st[2] + st[3]);
                const float rstd = __builtin_amdgcn_rsqf(ss * (1.0f / 1024.0f) + 1e-6f);
                const f32x4 g0 = acc[ai][0][m][0] * rstd, g1 = acc[ai][0][m][1] * rstd, u0 = acc[ai][1][m][0] * rstd, u1 = acc[ai][1][m][1] * rstd;
                *(u32x4*)(H + row * ldh + cl) = pack8(g0 * sig4(g0) * u0, g1 * sig4(g1) * u1); }
    }
};
template <class Epi, class Sched, bool ALIGN_EPI = false, bool SP2 = false>
__device__ __forceinline__ void gemm_phase(PG8_LAS unsigned char* lds, const Gemm g, const Sched& S, const Epi& E) {
    const int tid = threadIdx.x, wid = __builtin_amdgcn_readfirstlane(tid >> 6), lane = tid & 63, wr = wid >> 2, wc = wid & 3, fr = lane & 15, fq = lane >> 4;
    const int K = g.K, nt = K / BK;
    unsigned voffA[2], voffB[2];
#pragma unroll
    for (int i = 0; i < 2; ++i) { int R, C; stage_rc(tid * 16 + i * 8192, R, C); const int Rb = Epi::PERM ? ((R & ~31) + perm32(R & 31)) : R;
        voffA[i] = (unsigned)(R * K + C) * 2u; voffB[i] = (unsigned)(Rb * K + C) * 2u; }
    const size_t kstep = (size_t)(BK * 2);
    const size_t hstep = (size_t)HALF * K * 2;
    const size_t tstep = 2 * hstep;
    const unsigned ldsw = (unsigned)wid * 1024u;
    const int aoff = lds_byte(wr * 64 + fr, fq * 8), boff = lds_byte(wc * 32 + fr, fq * 8);
#define PG8_SA(b, h) (((b) * 2 + (h)) * HTB)
#define PG8_SB(b, h) ((4 + (b) * 2 + (h)) * HTB)
#define PG8_STAGE(bufoff, gbase, voff) do { _Pragma("unroll") for (int _i = 0; _i < 2; ++_i) \
        __builtin_amdgcn_global_load_lds((const unsigned*)((const char*)(gbase) + (voff)[_i]), (PG8_LAS unsigned*)(lds + (bufoff) + ldsw + _i * 8192), 16, 0, 0); } while (0)
#define PG8_LDA(dst, b, h) do { _Pragma("unroll") for (int m = 0; m < 4; ++m) _Pragma("unroll") for (int k = 0; k < 2; ++k) dst[m][k] = *(const PG8_LAS bf16x8*)(lds + PG8_SA(b, h) + aoff + m * 2048 + k * 1024); } while (0)
#define PG8_LDB(dst, b, h) do { _Pragma("unroll") for (int n = 0; n < 2; ++n) _Pragma("unroll") for (int k = 0; k < 2; ++k) dst[n][k] = *(const PG8_LAS bf16x8*)(lds + PG8_SB(b, h) + boff + n * 2048 + k * 1024); } while (0)
#define PG8_MMA(ai, bj, At, Bt) do { __builtin_amdgcn_s_setprio(1); _Pragma("unroll") for (int m = 0; m < 4; ++m) _Pragma("unroll") for (int n = 0; n < 2; ++n) _Pragma("unroll") for (int k = 0; k < 2; ++k) \
        acc[ai][bj][m][n] = __builtin_amdgcn_mfma_f32_16x16x32_bf16(Bt[n][k], At[m][k], acc[ai][bj][m][n], 0, 0, 0); __builtin_amdgcn_s_setprio(0); } while (0)
#define PG8_WAIT_V(n) asm volatile("s_waitcnt vmcnt(" #n ")" ::: "memory")
#define PG8_WAIT_L(n) asm volatile("s_waitcnt lgkmcnt(" #n ")" ::: "memory")
#define PG8_BAR __builtin_amdgcn_s_barrier()
#define PG8_SCHED __builtin_amdgcn_sched_barrier(0)
    Unit cur, nxt; int ui = 0;
    if (!S.next(0, cur)) return;
    f32x4 acc[2][2][4][2];
#pragma unroll
    for (int a = 0; a < 2; ++a)
#pragma unroll
        for (int b = 0; b < 2; ++b)
#pragma unroll
            for (int m = 0; m < 4; ++m)
#pragma unroll
                for (int n = 0; n < 2; ++n) acc[a][b][m][n] = (f32x4){0.f, 0.f, 0.f, 0.f};
    bf16x8 At[4][2], B0[2][2], B1[2][2];
    const char* cA = (const char*)g.A + (size_t)cur.pm * tstep; const char* cB = (const char*)g.Bt + (size_t)cur.pn * tstep;
    S.a_ready(cur);
    if constexpr (SP2) {
        PG8_STAGE(PG8_SB(0, 0), cB, voffB); PG8_STAGE(PG8_SB(0, 1), cB + hstep, voffB); PG8_STAGE(PG8_SA(0, 0), cA, voffA); PG8_STAGE(PG8_SA(0, 1), cA + hstep, voffA);
        if (wr == 1) PG8_BAR;
        PG8_WAIT_V(2); PG8_BAR;
        PG8_STAGE(PG8_SB(1, 0), cB + kstep, voffB); PG8_STAGE(PG8_SA(1, 0), cA + kstep, voffA); PG8_STAGE(PG8_SB(1, 1), cB + hstep + kstep, voffB);
        PG8_WAIT_V(6); PG8_BAR;
    } else {
        PG8_STAGE(PG8_SB(0, 0), cB, voffB); PG8_STAGE(PG8_SA(0, 0), cA, voffA); PG8_STAGE(PG8_SB(0, 1), cB + hstep, voffB); PG8_STAGE(PG8_SA(0, 1), cA + hstep, voffA);
        if (wr == 1) PG8_BAR;
        PG8_WAIT_V(4); PG8_BAR;
        PG8_STAGE(PG8_SB(1, 0), cB + kstep, voffB); PG8_STAGE(PG8_SA(1, 0), cA + kstep, voffA); PG8_STAGE(PG8_SB(1, 1), cB + hstep + kstep, voffB);
        PG8_WAIT_V(6); PG8_BAR;
    }
    for (;;) {
        const bool has_next = S.next(ui + 1, nxt);
        const char* nA = has_next ? (const char*)g.A + (size_t)nxt.pm * tstep : cA; const char* nB = has_next ? (const char*)g.Bt + (size_t)nxt.pn * tstep : cB;
        for (int t = 0; t < nt; t += 2) {
            const bool last = (t == nt - 2);
            const char* a1 = cA + (size_t)(t + 1) * kstep;
            const char* a2 = last ? nA : cA + (size_t)(t + 2) * kstep; const char* b2 = last ? nB : cB + (size_t)(t + 2) * kstep;
            const char* a3 = a2 + kstep; const char* b3 = b2 + kstep;
            if (last && has_next) S.a_ready(nxt);
            if constexpr (SP2) {
            PG8_LDB(B0, 0, 0); PG8_LDB(B1, 0, 1); PG8_SCHED; PG8_LDA(At, 0, 0); PG8_STAGE(PG8_SA(1, 1), a1 + hstep, voffA);
            PG8_WAIT_V(8); PG8_WAIT_L(0); PG8_BAR; PG8_MMA(0, 0, At, B0); PG8_MMA(0, 1, At, B1); PG8_BAR; PG8_SCHED;
            PG8_LDA(At, 0, 1); PG8_STAGE(PG8_SB(0, 0), b2, voffB); PG8_STAGE(PG8_SB(0, 1), b2 + hstep, voffB); PG8_STAGE(PG8_SA(0, 0), a2, voffA);
            PG8_WAIT_V(8); PG8_WAIT_L(0); PG8_BAR; PG8_MMA(1, 0, At, B0); PG8_MMA(1, 1, At, B1); PG8_BAR; PG8_SCHED;
            PG8_LDB(B0, 1, 0); PG8_LDB(B1, 1, 1); PG8_SCHED; PG8_LDA(At, 1, 0); PG8_STAGE(PG8_SA(0, 1), a2 + hstep, voffA);
            PG8_WAIT_V(8); PG8_WAIT_L(0); PG8_BAR; PG8_MMA(0, 0, At, B0); PG8_MMA(0, 1, At, B1); PG8_BAR; PG8_SCHED;
            PG8_LDA(At, 1, 1); PG8_STAGE(PG8_SB(1, 0), b3, voffB); PG8_STAGE(PG8_SB(1, 1), b3 + hstep, voffB); PG8_STAGE(PG8_SA(1, 0), a3, voffA);
            PG8_WAIT_V(8); PG8_WAIT_L(0); PG8_BAR; PG8_MMA(1, 0, At, B0); PG8_MMA(1, 1, At, B1); PG8_BAR; PG8_SCHED;
            } else {
            PG8_LDB(B0, 0, 0); PG8_SCHED; PG8_LDA(At, 0, 0); PG8_STAGE(PG8_SA(1, 1), a1 + hstep, voffA);
            PG8_WAIT_L(8); PG8_BAR; PG8_WAIT_L(0); PG8_MMA(0, 0, At, B0); PG8_BAR; PG8_SCHED;
            PG8_LDB(B1, 0, 1); PG8_STAGE(PG8_SB(0, 0), b2, voffB);
            PG8_BAR; PG8_WAIT_L(0); PG8_MMA(0, 1, At, B1); PG8_BAR;
            PG8_LDA(At, 0, 1); PG8_STAGE(PG8_SA(0, 0), a2, voffA);
            PG8_BAR; PG8_WAIT_L(0); PG8_MMA(1, 0, At, B0); PG8_BAR; PG8_SCHED;
            PG8_STAGE(PG8_SB(0, 1), b2 + hstep, voffB);
            PG8_WAIT_V(6); PG8_BAR; PG8_MMA(1, 1, At, B1); PG8_BAR;
            PG8_LDB(B0, 1, 0); PG8_SCHED; PG8_LDA(At, 1, 0); PG8_STAGE(PG8_SA(0, 1), a2 + hstep, voffA);
            PG8_WAIT_L(8); PG8_BAR; PG8_WAIT_L(0); PG8_MMA(0, 0, At, B0); PG8_BAR; PG8_SCHED;
            PG8_LDB(B1, 1, 1); PG8_STAGE(PG8_SB(1, 0), b3, voffB);
            PG8_BAR; PG8_WAIT_L(0); PG8_MMA(0, 1, At, B1); PG8_BAR;
            PG8_LDA(At, 1, 1); PG8_STAGE(PG8_SA(1, 0), a3, voffA);
            PG8_BAR; PG8_WAIT_L(0); PG8_MMA(1, 0, At, B0); PG8_BAR; PG8_SCHED;
            PG8_STAGE(PG8_SB(1, 1), b3 + hstep, voffB);
            PG8_WAIT_V(6); PG8_BAR; PG8_MMA(1, 1, At, B1); PG8_BAR;
            }
        }
        if constexpr (ALIGN_EPI) { if (wr == 0) PG8_BAR; }
        if constexpr (!Epi::AFTER_DRAIN) { E(acc, cur, wr, wc, fr, fq); S.done(cur); }
        if (!has_next) break;
#pragma unroll
        for (int a = 0; a < 2; ++a)
#pragma unroll
            for (int b = 0; b < 2; ++b)
#pragma unroll
                for (int m = 0; m < 4; ++m)
#pragma unroll
                    for (int n = 0; n < 2; ++n) acc[a][b][m][n] = (f32x4){0.f, 0.f, 0.f, 0.f};
        cur = nxt; cA = nA; cB = nB; ++ui;
        if constexpr (ALIGN_EPI) { if (wr == 1) PG8_BAR; }
    }
    PG8_WAIT_V(0);
    if constexpr (!ALIGN_EPI) { if (wr == 0) PG8_BAR; }
    PG8_BAR;
    if constexpr (Epi::AFTER_DRAIN) { E.fused(acc, cur, wr, wc, fr, fq, lds, wid, lane); S.done(cur); }
#undef PG8_SA
#undef PG8_SB
#undef PG8_STAGE
#undef PG8_LDA
#undef PG8_LDB
#undef PG8_MMA
#undef PG8_WAIT_V
#undef PG8_WAIT_L
#undef PG8_BAR
#undef PG8_SCHED
}
}
#define GAS __attribute__((address_space(1)))
#define LAS __attribute__((address_space(3)))
typedef unsigned short bf16;
typedef unsigned v4u __attribute__((ext_vector_type(4)));
typedef float f32x4 __attribute__((ext_vector_type(4)));
typedef short bf16x8 __attribute__((ext_vector_type(8)));
typedef GAS unsigned gu32;
typedef GAS unsigned long long gu64;
#define RLX_AGENT __ATOMIC_RELAXED, __HIP_MEMORY_SCOPE_AGENT
#define LDS_WAIT() asm volatile("s_waitcnt lgkmcnt(0)" ::: "memory")
#define VM_WAIT() asm volatile("s_waitcnt vmcnt(0)" ::: "memory")
__device__ __forceinline__ unsigned long long rt() { return __builtin_amdgcn_s_memrealtime(); }
__device__ __forceinline__ unsigned f2bf(float f) { unsigned u = __builtin_bit_cast(unsigned, f); return (u + 0x7fffu + ((u >> 16) & 1u)) >> 16; }
__device__ __forceinline__ unsigned pk2(float lo, float hi) { return f2bf(lo) | (f2bf(hi) << 16); }

#define XB_TMO      128
#define XB_XCNT(j)  (256  + 64 * (j))
#define XB_XSUB(j)  (1280 + 64 * (j))
#define XB_XGEN(j)  (2304 + 64 * (j))
#define XB_TOP      3328
#define XB_TOPGEN   3392
#define XCD_BAR_WORDS 3456
#define XB_SPIN_CAP (1u << 18)

__device__ __forceinline__ unsigned xb_ld(unsigned* p)              { return __hip_atomic_load(p, __ATOMIC_RELAXED, __HIP_MEMORY_SCOPE_AGENT); }
__device__ __forceinline__ unsigned xb_add(unsigned* p, unsigned v) { return __hip_atomic_fetch_add(p, v, __ATOMIC_RELAXED, __HIP_MEMORY_SCOPE_AGENT); }
__device__ __forceinline__ unsigned xb_xcc_id() { return (unsigned)__builtin_amdgcn_s_getreg((3 << 11) | 20) & 0xFu; }
#define XB_SPIN(cond, bar) do { unsigned _sp = 0; while (cond) { __builtin_amdgcn_s_sleep(1); \
    if ((++_sp & 255u) == 0u) { if (xb_ld(&(bar)[XB_TMO])) break; if (_sp > XB_SPIN_CAP) { atomicAdd(&(bar)[XB_TMO], 1u); break; } } } } while (0)

struct XcdBarrier {
    unsigned* bar; unsigned x;
    volatile LAS unsigned* st;
};

__device__ __forceinline__ XcdBarrier xcd_barrier_post(unsigned* bar, volatile LAS unsigned* st) {
    XcdBarrier b; b.bar = bar; b.x = xb_xcc_id(); b.st = st;
    if (threadIdx.x == 0) (void)xb_add(&bar[XB_XCNT(b.x)], 1u);
    return b;
}
__device__ __forceinline__ void xcd_barrier_complete(unsigned* bar, unsigned x, unsigned& nloc, unsigned& nx) {
    const unsigned G = gridDim.x * gridDim.y * gridDim.z;
    unsigned sum, cnt, mine, sp = 0u;
    for (;;) {
        sum = 0u; cnt = 0u; mine = 0u;
#pragma unroll
        for (unsigned j = 0; j < 16; ++j) { const unsigned c = xb_ld(&bar[XB_XCNT(j)]); sum += c; cnt += (c > 0u) ? 1u : 0u; mine = (j == x) ? c : mine; }
        if (sum == G) break;
        __builtin_amdgcn_s_sleep(1);
        if ((++sp & 255u) == 0u) { if (xb_ld(&bar[XB_TMO])) break; if (sp > XB_SPIN_CAP) { atomicAdd(&bar[XB_TMO], 1u); break; } }
    }
    nloc = mine > 0u ? mine : 1u; nx = cnt > 0u ? cnt : 1u;
}

__device__ __forceinline__ void xcd_barrier(const XcdBarrier& b) {
    asm volatile("s_waitcnt vmcnt(0)" ::: "memory");
    __syncthreads();
    if (threadIdx.x == 0) {
        unsigned* bar = b.bar;
        __builtin_amdgcn_s_waitcnt(0);
        unsigned nloc = b.st[0], nx = b.st[1];
        if (nloc == 0u) { xcd_barrier_complete(bar, b.x, nloc, nx); b.st[0] = nloc; b.st[1] = nx; }
        const unsigned old = xb_add(&bar[XB_XSUB(b.x)], 1u);
        const unsigned gen = old / nloc;
        if (old + 1u == (gen + 1u) * nloc) {
            __builtin_amdgcn_fence(__ATOMIC_RELEASE, "agent");
            asm volatile("s_waitcnt vmcnt(0)" ::: "memory");
            const unsigned og = xb_add(&bar[XB_TOP], 1u);
            const unsigned tg = og / nx;
            if (og + 1u == (tg + 1u) * nx) xb_add(&bar[XB_TOPGEN], 1u);
            else XB_SPIN(xb_ld(&bar[XB_TOPGEN]) == tg, bar);
            __builtin_amdgcn_fence(__ATOMIC_ACQUIRE, "agent");
            xb_add(&bar[XB_XGEN(b.x)], 1u);
            asm volatile("s_waitcnt vmcnt(0)" ::: "memory");
        } else {
            XB_SPIN(xb_ld(&bar[XB_XGEN(b.x)]) == gen, bar);
            __builtin_amdgcn_fence(__ATOMIC_ACQUIRE, "agent");
            asm volatile("s_waitcnt vmcnt(0)" ::: "memory");
        }
    }
    __syncthreads();
}

constexpr int NWAVES = 8;
#ifndef MK_N_LAUNCHES
#define MK_N_LAUNCHES 1
#endif
constexpr int N_PHASES = 8;
constexpr int BATCH = 8, SEQ = 2048, D = 1024, M = BATCH * SEQ;
constexpr int CC = 512, CW = 31, DFF = 2816, NIN = 4296, NU = 4352;
constexpr float QSC = 0.125f * 1.4426950408889634f;
constexpr size_t MiB = 1u << 20;
constexpr size_t WS_CTL = 0, CTL_ZERO_BYTES = 1 * MiB;
constexpr size_t WS_WIN = 1 * MiB, WS_WCO = 10 * MiB, WS_WAO = 11 * MiB, WS_WOUT = 12 * MiB, WS_WGU = 14 * MiB, WS_WD = 25 * MiB, WS_SS = 31 * MiB;
constexpr size_t WS_R2 = 32 * MiB;
constexpr size_t WS_G = 64 * MiB;
constexpr size_t WS_GLU = 128 * MiB, WS_Q = 144 * MiB, WS_QI = 160 * MiB, WS_C = 176 * MiB, WS_A = 192 * MiB;
constexpr size_t WS_K = 208 * MiB, WS_V = 210 * MiB, WS_KI = 212 * MiB, WS_WI = 214 * MiB;
constexpr size_t WS_MG = 216 * MiB;
constexpr size_t WS_HFF = 64 * MiB;
constexpr size_t WS_END = 256 * MiB;
static_assert(WS_WIN + (size_t)NU * D * 2 <= WS_WCO && WS_WGU + (size_t)2 * DFF * D * 2 <= WS_WD && WS_WD + (size_t)D * DFF * 2 <= WS_SS && WS_SS + (size_t)M * 16 * 4 <= WS_R2, "weights map");
static_assert(WS_HFF + (size_t)M * DFF * 2 <= WS_QI && WS_MG + (size_t)M * D * 2 <= WS_END && WS_WI + (size_t)M * 8 * 4 <= WS_MG, "activation map");
constexpr int CW_BAR = 4096;
constexpr int RING_OFF = 0, RING_BYTES = 131072;
constexpr int LDSCTL_OFF = RING_BYTES, MISC_OFF = LDSCTL_OFF + 320;
constexpr int LDS_BYTES = 147456;

struct Frame {
    LAS unsigned char* lds; volatile LAS unsigned* MISC; gu32* ctl;
    int tid, lane, wave, vcu, G;
};
__device__ __forceinline__ float wave_sum(float v) {
#pragma unroll
    for (int o = 1; o < 64; o <<= 1) v += __shfl_xor(v, o);
    return v;
}
__device__ __forceinline__ float bf2f(bf16 h) { return __uint_as_float((unsigned)h << 16); }
__device__ __forceinline__ float bflo(unsigned w) { return __uint_as_float(w << 16); }
__device__ __forceinline__ float bfhi(unsigned w) { return __uint_as_float(w & 0xffff0000u); }
__device__ __forceinline__ float sigmoidf_(float x) { return __builtin_amdgcn_rcpf(1.0f + __expf(-x)); }

template <class MapF>
__device__ __forceinline__ void p0_transpose_item(const float* W, int K, int N, bf16* WT, LAS float* scr, int item, int lane, const float* kscale, MapF dst) {
    const int nblk = (N + 31) / 32, kb = item / nblk, nb = item % nblk, k0 = 64 * kb, n0 = 32 * nb;
    const int nl = n0 + (lane & 31);
#pragma unroll 8
    for (int i = 0; i < 32; ++i) { const int kk = 2 * i + (lane >> 5); float v = (nl < N) ? W[(size_t)(k0 + kk) * N + nl] : 0.f; if (kscale) v *= kscale[k0 + kk]; scr[kk * 33 + (lane & 31)] = v; }
    LDS_WAIT(); asm volatile("" ::: "memory");
    const int c = lane & 7;
#pragma unroll
    for (int j = 0; j < 4; ++j) { const int n = (lane >> 3) + 8 * j; const LAS float* s = scr + (8 * c) * 33 + n;
        v4u o; o.x = pk2(s[0 * 33], s[1 * 33]); o.y = pk2(s[2 * 33], s[3 * 33]); o.z = pk2(s[4 * 33], s[5 * 33]); o.w = pk2(s[6 * 33], s[7 * 33]);
        if (n0 + n < N) *(GAS v4u*)(WT + (size_t)dst(n0 + n) * K + k0 + 8 * c) = o; }
    LDS_WAIT(); asm volatile("" ::: "memory");
}
struct MapId { __device__ __forceinline__ int operator()(int n) const { return n; } };
struct MapWin {
    __device__ __forceinline__ int operator()(int n) const {
        if (n < 512) return 256 * (n >> 7) + (n & 127);
        if (n < 1024) { const int c = n - 512; return 256 * (c >> 7) + 128 + (c & 127); }
        if (n < 1536) return n;
        if (n < 1600) return 2048 + (n - 1536);
        if (n < 1664) return 2048 + 64 + (n - 1600);
        if (n < 2176) return 1536 + (n - 1664);
        if (n < 2240) return 2048 + 128 + (n - 2176);
        if (n < 2248) return 2048 + 192 + (n - 2240);
        return 2304 + (n - 2248);
    }
};
struct MapGU { int up; __device__ __forceinline__ int operator()(int n) const { return 256 * (n >> 7) + 128 * up + (n & 127); } };

__device__ __forceinline__ void rms_row_to_bf16(int lane, const float* xrow, const float* g, bf16* orow) {
    const GAS f32x4* xr = (const GAS f32x4*)xrow + lane; f32x4 v[4]; float s = 0.f;
#pragma unroll
    for (int j = 0; j < 4; ++j) { v[j] = xr[64 * j]; s += (v[j].x * v[j].x + v[j].y * v[j].y) + (v[j].z * v[j].z + v[j].w * v[j].w); }
    const float rstd = 1.f / sqrtf(wave_sum(s) * (1.f / D) + 1e-6f);
    GAS unsigned long long* o8 = (GAS unsigned long long*)orow + lane;
#pragma unroll
    for (int j = 0; j < 4; ++j) { const f32x4 gv = ((const GAS f32x4*)g)[lane + 64 * j];
        o8[64 * j] = (unsigned long long)pk2(v[j].x * rstd * gv.x, v[j].y * rstd * gv.y) | ((unsigned long long)pk2(v[j].z * rstd * gv.z, v[j].w * rstd * gv.w) << 32); }
}
struct Args { const float* in[16]; float* out; unsigned char* ws; int ph_lo, ph_hi; };

__device__ __forceinline__ void p0_prologue(Frame& F, const Args& a) {
    LAS float* scr = (LAS float*)(F.lds + RING_OFF + F.wave * 16384);
    const int gw = F.vcu * NWAVES + F.wave, NGW = F.G * NWAVES;
    unsigned char* ws = a.ws;
    constexpr int I_IN = (D / 64) * ((NIN + 31) / 32), I_CO = (CC / 64) * (D / 32), I_OUT = (D / 64) * (D / 32), I_G = (D / 64) * (DFF / 32), I_D = (DFF / 64) * (D / 32);
    constexpr int NITEMS = I_IN + 2 * I_CO + I_OUT + 2 * I_G + I_D;
    for (int it = gw; it < NITEMS; it += NGW) {
        int r = it;
        if (r < I_IN) { p0_transpose_item(a.in[2], D, NIN, (bf16*)(ws + WS_WIN), scr, r, F.lane, nullptr, MapWin{}); continue; } r -= I_IN;
        if (r < I_CO) { p0_transpose_item(a.in[8], CC, D, (bf16*)(ws + WS_WCO), scr, r, F.lane, nullptr, MapId{}); continue; } r -= I_CO;
        if (r < I_CO) { p0_transpose_item(a.in[9], CC, D, (bf16*)(ws + WS_WAO), scr, r, F.lane, nullptr, MapId{}); continue; } r -= I_CO;
        if (r < I_OUT) { p0_transpose_item(a.in[10], D, D, (bf16*)(ws + WS_WOUT), scr, r, F.lane, nullptr, MapId{}); continue; } r -= I_OUT;
        if (r < I_G) { p0_transpose_item(a.in[12], D, DFF, (bf16*)(ws + WS_WGU), scr, r, F.lane, a.in[11], MapGU{0}); continue; } r -= I_G;
        if (r < I_G) { p0_transpose_item(a.in[13], D, DFF, (bf16*)(ws + WS_WGU), scr, r, F.lane, a.in[11], MapGU{1}); continue; } r -= I_G;
        p0_transpose_item(a.in[14], DFF, D, (bf16*)(ws + WS_WD), scr, r, F.lane, nullptr, MapId{});
    }
    for (int m = gw; m < M; m += NGW) rms_row_to_bf16(F.lane, a.in[0] + (size_t)m * D, a.in[1], (bf16*)(ws + WS_R2) + (size_t)m * D);
}

__device__ __forceinline__ void conv_phase(Frame& F, const Args& a) {
    const float* conv_w = a.in[4]; const float* conv_b = a.in[5]; const float* ln_g = a.in[6]; const float* ln_b = a.in[7];
    const bf16* GLU = (const bf16*)(a.ws + WS_GLU); bf16* C = (bf16*)(a.ws + WS_C);
    LAS float* Wl = (LAS float*)(F.lds + RING_OFF);
    LAS float* Pl = (LAS float*)(F.lds + RING_OFF + 65536);
    for (int i = F.tid; i < CW * CC; i += NWAVES * 64) Wl[i] = conv_w[i];
    __syncthreads();
    const int g = F.wave >> 2, cw = F.wave & 3, ch = 128 * cw + 2 * F.lane;
    const float cb0 = conv_b[ch], cb1 = conv_b[ch + 1], lg0 = ln_g[ch], lg1 = ln_g[ch + 1], lb0 = ln_b[ch], lb1 = ln_b[ch + 1];
    for (int unit = F.vcu; unit < M / 32; unit += F.G) {
        const int m0 = unit * 32 + 16 * g, t0 = m0 % SEQ;
        float x0[46], x1[46];
#pragma unroll
        for (int r = 0; r < 46; ++r) { const int t = t0 - 30 + r; const unsigned w = (t >= 0) ? *(const GAS unsigned*)(GLU + (size_t)(m0 - 30 + r) * CC + ch) : 0u; x0[r] = bflo(w); x1[r] = bfhi(w); }
        float a0[16], a1[16];
#pragma unroll
        for (int tt = 0; tt < 16; ++tt) { a0[tt] = cb0; a1[tt] = cb1; }
#pragma unroll
        for (int j = 0; j < CW; ++j) { const float w0 = Wl[j * CC + ch], w1 = Wl[j * CC + ch + 1];
#pragma unroll
            for (int tt = 0; tt < 16; ++tt) { a0[tt] += w0 * x0[tt + j]; a1[tt] += w1 * x1[tt + j]; } }
#pragma unroll
        for (int tt = 0; tt < 16; ++tt) { const float s1 = wave_sum(a0[tt] + a1[tt]), s2 = wave_sum(a0[tt] * a0[tt] + a1[tt] * a1[tt]);
            if (F.lane == 0) { Pl[((g * 16 + tt) * 4 + cw) * 2] = s1; Pl[((g * 16 + tt) * 4 + cw) * 2 + 1] = s2; } }
        __syncthreads();
#pragma unroll
        for (int tt = 0; tt < 16; ++tt) { const LAS float* p = Pl + (g * 16 + tt) * 8;
            const float s1 = (p[0] + p[2]) + (p[4] + p[6]), s2 = (p[1] + p[3]) + (p[5] + p[7]);
            const float mu = s1 * (1.f / CC), var = s2 * (1.f / CC) - mu * mu, rstd = 1.f / sqrtf(fmaxf(var, 0.f) + 1e-5f);
            const float z0 = (a0[tt] - mu) * rstd * lg0 + lb0, z1 = (a1[tt] - mu) * rstd * lg1 + lb1;
            *(GAS unsigned*)(C + (size_t)(m0 + tt) * CC + ch) = pk2(z0 * sigmoidf_(z0), z1 * sigmoidf_(z1)); }
        __syncthreads();
    }
}

__device__ __forceinline__ unsigned fkey(float f) { f += 0.0f; const unsigned u = __float_as_uint(f); return (u & 0x80000000u) ? ~u : (u | 0x80000000u); }
__device__ __forceinline__ void attn_simple(Frame& F, const Args& a) {
    const bf16* Q = (const bf16*)(a.ws + WS_Q); const bf16* QI = (const bf16*)(a.ws + WS_QI); const bf16* Kb = (const bf16*)(a.ws + WS_K); const bf16* Vb = (const bf16*)(a.ws + WS_V);
    const bf16* KI = (const bf16*)(a.ws + WS_KI); const float* WI = (const float*)(a.ws + WS_WI); bf16* A = (bf16*)(a.ws + WS_A);
    LAS unsigned* keys = (LAS unsigned*)(F.lds + RING_OFF);
    LAS float* qs = (LAS float*)(F.lds + RING_OFF + 8192);
    LAS float* att = (LAS float*)(F.lds + RING_OFF + 10240);
    LAS int* sel = (LAS int*)(F.lds + RING_OFF + 18432);
    LAS float* sm = (LAS float*)(F.lds + RING_OFF + 19456);
    LAS unsigned* cnt = (LAS unsigned*)(F.lds + RING_OFF + 19584);
    const int tid = F.tid, NT = NWAVES * 64;
    for (int qi = 0;; ++qi) {
        const int m = qi * F.G + F.vcu; if (m >= M) break;
        const int b = m / SEQ, t = m % SEQ;
        for (int i = tid; i < 512; i += NT) qs[i] = bf2f(QI[(size_t)m * 512 + i]);
        if (tid < 8) sm[tid] = WI[(size_t)m * 8 + tid];
        __syncthreads();
        for (int s = tid; s < SEQ; s += NT) {
            unsigned key = 0u;
            if (s <= t) {
                const bf16* kr = KI + ((size_t)b * SEQ + s) * 64; float kv[64];
#pragma unroll
                for (int e = 0; e < 64; ++e) kv[e] = bf2f(kr[e]);
                float sc = 0.f;
                for (int h = 0; h < 8; ++h) { float d = 0.f;
#pragma unroll
                    for (int e = 0; e < 64; ++e) d += qs[h * 64 + e] * kv[e];
                    sc += sm[h] * fmaxf(d, 0.f); }
                key = fkey(sc);
            }
            keys[s] = key;
        }
        __syncthreads();
        const int nsel = (t + 1 < 256) ? (t + 1) : 256;
        if (t + 1 <= 256) { for (int s = tid; s <= t; s += NT) sel[s] = s; }
        else {
            unsigned T = 0u;
            for (int bit = 31; bit >= 0; --bit) {
                const unsigned cand = T | (1u << bit);
                if (tid == 0) cnt[0] = 0u;
                __syncthreads();
                unsigned c = 0;
#pragma unroll
                for (int i = 0; i < SEQ / (NWAVES * 64); ++i) c += (keys[tid + i * NT] >= cand) ? 1u : 0u;
#pragma unroll
                for (int o = 1; o < 64; o <<= 1) c += __shfl_xor(c, o);
                if (F.lane == 0 && c) atomicAdd((unsigned*)cnt, c);
                __syncthreads();
                if (cnt[0] >= 256u) T = cand;
                __syncthreads();
            }
            if (F.wave == 0) {
                int base = 0;
                for (int s0 = 0; s0 <= t; s0 += 64) { const int s = s0 + F.lane; const bool p = (s <= t) && (keys[s] > T);
                    const unsigned long long bm = __ballot(p); const int pos = base + __builtin_amdgcn_mbcnt_hi((unsigned)(bm >> 32), __builtin_amdgcn_mbcnt_lo((unsigned)bm, 0u));
                    if (p) sel[pos] = s; base += __builtin_popcountll(bm); }
                for (int s0 = 0; s0 <= t && base < 256; s0 += 64) { const int s = s0 + F.lane; const bool p = (s <= t) && (keys[s] == T);
                    const unsigned long long bm = __ballot(p); const int pos = base + __builtin_amdgcn_mbcnt_hi((unsigned)(bm >> 32), __builtin_amdgcn_mbcnt_lo((unsigned)bm, 0u));
                    if (p && pos < 256) sel[pos] = s; base += __builtin_popcountll(bm); }
            }
        }
        for (int i = tid; i < 512; i += NT) qs[i] = bf2f(Q[(size_t)m * 512 + i]);
        __syncthreads();
        for (int idx = tid; idx < 8 * 256; idx += NT) { const int h = idx >> 8, k = idx & 255;
            if (k < nsel) { const int s = sel[k]; const bf16* kr = Kb + ((size_t)b * SEQ + s) * 64; float d = 0.f;
#pragma unroll
                for (int e = 0; e < 64; ++e) d += qs[h * 64 + e] * bf2f(kr[e]);
                att[h * 256 + k] = d - exp2f(-(float)(h + 1)) * 1.4426950408889634f * (float)(t - s); } }
        __syncthreads();
        if (tid < 8) { float mx = -INFINITY; for (int k = 0; k < nsel; ++k) mx = fmaxf(mx, att[tid * 256 + k]); float l = 0.f; for (int k = 0; k < nsel; ++k) l += exp2f(att[tid * 256 + k] - mx); sm[8 + tid] = mx; sm[16 + tid] = l; }
        __syncthreads();
        for (int idx = tid; idx < 8 * 256; idx += NT) { const int h = idx >> 8, k = idx & 255; att[idx] = (k < nsel) ? exp2f(att[idx] - sm[8 + h]) / sm[16 + h] : 0.f; }
        __syncthreads();
        { const int h = tid >> 6, d = tid & 63; float o = 0.f;
            for (int k = 0; k < nsel; ++k) o += att[h * 256 + k] * bf2f(Vb[((size_t)b * SEQ + sel[k]) * 64 + d]);
            A[(size_t)m * 512 + tid] = (bf16)f2bf(o); }
        __syncthreads();
    }
}

typedef float f32x16 __attribute__((ext_vector_type(16)));
typedef short s16x4 __attribute__((ext_vector_type(4)));
constexpr int ATT_KI = 0, ATT_K = 32768, ATT_V = 65536, ATT_MB = 98304, ATT_WV = 106496, ATT_CHB = 16384;

__device__ __forceinline__ void att_stage(LAS unsigned char* dst, const bf16* src, int wave, int lane, bool vswz) {
#pragma unroll
    for (int i = 0; i < 2; ++i) { const int p = wave + 8 * i, row = 8 * p + (lane >> 3), pos = lane & 7;
        const int c = vswz ? (pos ^ (((row >> 1) & 1) << 2)) : (pos ^ ((row >> 1) & 7));
        __builtin_amdgcn_global_load_lds((const unsigned*)((const char*)src + row * 128 + c * 16), (LAS unsigned*)(dst + p * 1024), 16, 0, 0); }
}
__device__ __forceinline__ unsigned half_sum(unsigned v) {
#pragma unroll
    for (int o = 1; o < 32; o <<= 1) v += (unsigned)__shfl_xor((int)v, o);
    return v;
}
#define ATT_CNT(n, key, cand) asm("v_cmp_ge_u32 vcc, %1, %2\n\tv_addc_co_u32 %0, vcc, 0, %0, vcc" : "+v"(n) : "v"(key), "v"(cand) : "vcc")
#define ATT_CNTGT(n, key, cand) asm("v_cmp_gt_u32 vcc, %1, %2\n\tv_addc_co_u32 %0, vcc, 0, %0, vcc" : "+v"(n) : "v"(key), "v"(cand) : "vcc")

__device__ __forceinline__ void attn_phase(Frame& F, const Args& a) {
    const bf16* Qg = (const bf16*)(a.ws + WS_Q); const bf16* QIg = (const bf16*)(a.ws + WS_QI); const bf16* Kg = (const bf16*)(a.ws + WS_K); const bf16* Vg = (const bf16*)(a.ws + WS_V);
    const bf16* KIg = (const bf16*)(a.ws + WS_KI); const float* WIg = (const float*)(a.ws + WS_WI); bf16* Ag = (bf16*)(a.ws + WS_A);
    LAS unsigned char* L = F.lds + RING_OFF;
    const int lane = F.lane, wave = F.wave;
    LAS unsigned* MB = (LAS unsigned*)(L + ATT_MB) + wave * 256;
    LAS f32x4* WV = (LAS f32x4*)(L + ATT_WV) + wave * 8;
    LAS unsigned* SKL = (LAS unsigned*)(L + ATT_K) + wave * 2048 + lane;
    for (int u = F.vcu, ku = 0; u < BATCH * 64; u += F.G, ++ku) {
        int b, j;
        if (F.G == 256) { b = F.vcu >> 5; const int i = F.vcu & 31; j = ku ? 63 - i : i; }
        else { b = u >> 6; j = u & 63; }
        const int ntile = j + 1, nch = (ntile + 3) >> 2, T0 = 32 * j, t0 = T0 + 4 * wave;
        const size_t rowb = (size_t)b * SEQ;
        const int n = lane & 31, hf = lane >> 5;
        const int offk0 = n * 128 + (((hf ^ ((n >> 1) & 7))) << 4);
        bf16x8 aq[4];
        {   const int qq = 2 * ((n >> 2) & 1) + (n >> 4), h = (n & 3) + 4 * ((n >> 3) & 1);
            const bf16* qp = QIg + (rowb + t0 + qq) * 512 + h * 64 + 8 * hf;
#pragma unroll
            for (int s = 0; s < 4; ++s) aq[s] = *(const bf16x8*)(qp + 16 * s);
            if (n < 4) WV[hf * 4 + n] = *(const f32x4*)(WIg + (rowb + t0 + 2 * hf) * 8 + 4 * n); }
        unsigned sk[48][2];
#pragma unroll
        for (int t = 0; t < 48; ++t) { sk[t][0] = 0u; sk[t][1] = 0u; }
#pragma unroll
        for (int t = 0; t < 16; ++t) if (t >= ntile) { SKL[(2 * t) * 64] = 0u; SKL[(2 * t + 1) * 64] = 0u; }
        att_stage(L + ATT_KI, KIg + rowb * 64, wave, lane, false);
        LDS_WAIT(); VM_WAIT(); __syncthreads();
        const int lim0 = 4 * wave + 2 * hf, lim1 = lim0 + 1;
#pragma unroll
        for (int c = 0; c < 16; ++c) if (c < nch) {
            if (c + 1 < nch) att_stage(L + ATT_KI + ((c + 1) & 1) * ATT_CHB, KIg + (rowb + 128 * (c + 1)) * 64, wave, lane, false);
#pragma unroll
            for (int tt = 0; tt < 4; ++tt) { const int tau = 4 * c + tt; if (tau < ntile) {
                const LAS unsigned char* kb = L + ATT_KI + (c & 1) * ATT_CHB + tt * 4096;
                f32x16 acc = {0.f, 0.f, 0.f, 0.f, 0.f, 0.f, 0.f, 0.f, 0.f, 0.f, 0.f, 0.f, 0.f, 0.f, 0.f, 0.f};
#pragma unroll
                for (int s = 0; s < 4; ++s) { acc = __builtin_amdgcn_mfma_f32_32x32x16_bf16(aq[s], *(const LAS bf16x8*)(kb + (offk0 ^ (32 * s))), acc, 0, 0, 0); if (s == 1) __builtin_amdgcn_sched_barrier(0); }
                float s0 = 0.f, s1 = 0.f;
                {   const f32x4 wa = WV[hf * 4], wb = WV[hf * 4 + 1];
#pragma unroll
                    for (int i = 0; i < 4; ++i) { s0 = fmaf(fmaxf(acc[i], 0.f), wa[i], s0); s0 = fmaf(fmaxf(acc[4 + i], 0.f), wb[i], s0); } }
                {   const f32x4 wa = WV[hf * 4 + 2], wb = WV[hf * 4 + 3];
#pragma unroll
                    for (int i = 0; i < 4; ++i) { s1 = fmaf(fmaxf(acc[8 + i], 0.f), wa[i], s1); s1 = fmaf(fmaxf(acc[12 + i], 0.f), wb[i], s1); } }
                const bool diag = (tau == j);
                const bool v0 = !diag || (n <= lim0), v1 = !diag || (n <= lim1);
                if (tau < 16) { SKL[(2 * tau) * 64] = v0 ? fkey(s0) : 0u; SKL[(2 * tau + 1) * 64] = v1 ? fkey(s1) : 0u; }
                else { sk[tau - 16][0] = v0 ? fkey(s0) : 0u; sk[tau - 16][1] = v1 ? fkey(s1) : 0u; }
                __builtin_amdgcn_sched_barrier(0);
            } }
            VM_WAIT(); __syncthreads();
        }
        LDS_WAIT();
        unsigned Th0 = 0u, Th1 = 0u;
        bool d0 = (t0 + 2 * hf + 1) <= 256, d1 = (t0 + 2 * hf + 2) <= 256;
        if (d0) Th0 = 1u;
        if (d1) Th1 = 1u;
        for (int bit = 31; bit >= 0; --bit) {
            if (__all(d0 && d1)) break;
            const unsigned c0 = Th0 | (1u << bit), c1 = Th1 | (1u << bit);
            unsigned n0 = 0u, n1 = 0u;
#pragma unroll
            for (int g = 0; g < 2; ++g) if (g * 8 < ntile) {
#pragma unroll
                for (int uu = 0; uu < 8; ++uu) { const unsigned k0 = SKL[(2 * (g * 8 + uu)) * 64], k1 = SKL[(2 * (g * 8 + uu) + 1) * 64]; ATT_CNT(n0, k0, c0); ATT_CNT(n1, k1, c1); } }
#pragma unroll
            for (int g = 2; g < 8; ++g) if (g * 8 < ntile) {
#pragma unroll
                for (int uu = 0; uu < 8; ++uu) { ATT_CNT(n0, sk[g * 8 + uu - 16][0], c0); ATT_CNT(n1, sk[g * 8 + uu - 16][1], c1); } }
            n0 = half_sum(n0); n1 = half_sum(n1);
            if (!d0 && n0 >= 256u) { Th0 = c0; d0 = (n0 == 256u); }
            if (!d1 && n1 >= 256u) { Th1 = c1; d1 = (n1 == 256u); }
        }
        unsigned need0, need1;
        {   unsigned g0 = 0u, g1 = 0u;
#pragma unroll
            for (int g = 0; g < 2; ++g) if (g * 8 < ntile) {
#pragma unroll
                for (int uu = 0; uu < 8; ++uu) { const unsigned k0 = SKL[(2 * (g * 8 + uu)) * 64], k1 = SKL[(2 * (g * 8 + uu) + 1) * 64]; ATT_CNTGT(g0, k0, Th0); ATT_CNTGT(g1, k1, Th1); } }
#pragma unroll
            for (int g = 2; g < 8; ++g) if (g * 8 < ntile) {
#pragma unroll
                for (int uu = 0; uu < 8; ++uu) { ATT_CNTGT(g0, sk[g * 8 + uu - 16][0], Th0); ATT_CNTGT(g1, sk[g * 8 + uu - 16][1], Th1); } }
            g0 = half_sum(g0); g1 = half_sum(g1); need0 = 256u - g0; need1 = 256u - g1; }
        {   unsigned run0 = 0u, run1 = 0u, mq0 = 0u, mq1 = 0u, mq2 = 0u, mq3 = 0u;
#pragma unroll
            for (int t = 0; t < 64; ++t) if (t < ntile) {
                {   const unsigned kk = (t < 16) ? SKL[(2 * t) * 64] : sk[t < 16 ? 0 : t - 16][0]; const bool gt = kk > Th0, eq = kk == Th0; const unsigned long long be = __ballot(eq);
                    const unsigned lo = (unsigned)be, hi = (unsigned)(be >> 32);
                    const unsigned rank = run0 + (hf ? __builtin_amdgcn_mbcnt_hi(hi, 0u) : __builtin_amdgcn_mbcnt_lo(lo, 0u));
                    const bool sel = gt || (eq && rank < need0); run0 += hf ? __builtin_popcount(hi) : __builtin_popcount(lo);
                    const unsigned long long bs = __ballot(sel);
                    if (lane == t) { mq0 = (unsigned)bs; mq2 = (unsigned)(bs >> 32); } }
                {   const unsigned kk = (t < 16) ? SKL[(2 * t + 1) * 64] : sk[t < 16 ? 0 : t - 16][1]; const bool gt = kk > Th1, eq = kk == Th1; const unsigned long long be = __ballot(eq);
                    const unsigned lo = (unsigned)be, hi = (unsigned)(be >> 32);
                    const unsigned rank = run1 + (hf ? __builtin_amdgcn_mbcnt_hi(hi, 0u) : __builtin_amdgcn_mbcnt_lo(lo, 0u));
                    const bool sel = gt || (eq && rank < need1); run1 += hf ? __builtin_popcount(hi) : __builtin_popcount(lo);
                    const unsigned long long bs = __ballot(sel);
                    if (lane == t) { mq1 = (unsigned)bs; mq3 = (unsigned)(bs >> 32); } }
            }
            MB[lane] = mq0; MB[64 + lane] = mq1; MB[128 + lane] = mq2; MB[192 + lane] = mq3; }
        int lane2 = lane; asm volatile("" : "+v"(lane2));
        const int n2 = lane2 & 31, hf2 = lane2 >> 5, q = n2 >> 3, h = n2 & 7;
        const int g16 = lane2 >> 4, qr = (lane2 & 15) >> 2, pp = lane2 & 3;
        const int offk2 = n2 * 128 + (((hf2 ^ ((n2 >> 1) & 7))) << 4);
        int offv[2];
#pragma unroll
        for (int mt = 0; mt < 2; ++mt) { const int c = 4 * mt + 2 * (g16 & 1) + (pp >> 1), pos = c ^ (4 * (qr >> 1)); offv[mt] = (4 * hf2 + qr) * 128 + pos * 16 + 8 * (pp & 1); }
        bf16x8 bq[4];
        {   const bf16* qp = Qg + (rowb + t0 + q) * 512 + h * 64 + 8 * hf2;
#pragma unroll
            for (int s = 0; s < 4; ++s) bq[s] = *(const bf16x8*)(qp + 16 * s); }
        const float sl = exp2f(-(float)(h + 1)) * 1.4426950408889634f;
        float slc[16];
#pragma unroll
        for (int i = 0; i < 16; ++i) slc[i] = sl * (float)((i & 3) + 8 * (i >> 2));
        f32x16 o0 = {0.f, 0.f, 0.f, 0.f, 0.f, 0.f, 0.f, 0.f, 0.f, 0.f, 0.f, 0.f, 0.f, 0.f, 0.f, 0.f}, o1 = o0;
        float mrun = -INFINITY, lrun = 0.f;
        const LAS unsigned* mrow = MB + q * 64;
        LDS_WAIT(); __syncthreads();
        att_stage(L + ATT_K + ((nch - 1) & 1) * ATT_CHB, Kg + (rowb + 128 * (nch - 1)) * 64, wave, lane, false);
        att_stage(L + ATT_V + ((nch - 1) & 1) * ATT_CHB, Vg + (rowb + 128 * (nch - 1)) * 64, wave, lane, true);
        VM_WAIT(); __syncthreads();
        for (int c = nch - 1; c >= 0; --c) {
            if (c > 0) { att_stage(L + ATT_K + ((c - 1) & 1) * ATT_CHB, Kg + (rowb + 128 * (c - 1)) * 64, wave, lane, false);
                         att_stage(L + ATT_V + ((c - 1) & 1) * ATT_CHB, Vg + (rowb + 128 * (c - 1)) * 64, wave, lane, true); }
            for (int tt = 3; tt >= 0; --tt) { const int tau = 4 * c + tt; if (tau >= ntile) continue;
                const LAS unsigned char* kb = L + ATT_K + (c & 1) * ATT_CHB + tt * 4096; const LAS unsigned char* vb = L + ATT_V + (c & 1) * ATT_CHB + tt * 4096;
                const float base = sl * (float)(32 * tau + 4 * hf2 - (t0 + q));
                const unsigned mw = mrow[tau] >> (4 * hf2);
                f32x16 sacc;
#pragma unroll
                for (int i = 0; i < 16; ++i) sacc[i] = base + slc[i];
#pragma unroll
                for (int s = 0; s < 4; ++s) sacc = __builtin_amdgcn_mfma_f32_32x32x16_bf16(*(const LAS bf16x8*)(kb + (offk2 ^ (32 * s))), bq[s], sacc, 0, 0, 0);
                float mx = -INFINITY;
#pragma unroll
                for (int i = 0; i < 16; ++i) { const float v = (mw & (1u << ((i & 3) + 8 * (i >> 2)))) ? sacc[i] : -INFINITY; sacc[i] = v; mx = fmaxf(mx, v); }
                mx = fmaxf(mx, __shfl_xor(mx, 32));
                const float mnew = fmaxf(mrun, mx), msafe = (mnew == -INFINITY) ? 0.f : mnew;
                const float alpha = __builtin_amdgcn_exp2f(mrun - msafe);
                float ps = 0.f;
#pragma unroll
                for (int i = 0; i < 16; ++i) { const float p = __builtin_amdgcn_exp2f(sacc[i] - msafe); sacc[i] = p; ps += p; }
                lrun = lrun * alpha + ps;
                if (__any(mnew != mrun)) {
#pragma unroll
                    for (int i = 0; i < 16; ++i) { o0[i] *= alpha; o1[i] *= alpha; } }
                mrun = mnew;
                bf16x8 pb[2];
#pragma unroll
                for (int s2 = 0; s2 < 2; ++s2) { v4u w; w.x = pg8::cvt_pk_bf16(sacc[8 * s2 + 0], sacc[8 * s2 + 1]); w.y = pg8::cvt_pk_bf16(sacc[8 * s2 + 2], sacc[8 * s2 + 3]);
                    w.z = pg8::cvt_pk_bf16(sacc[8 * s2 + 4], sacc[8 * s2 + 5]); w.w = pg8::cvt_pk_bf16(sacc[8 * s2 + 6], sacc[8 * s2 + 7]); pb[s2] = __builtin_bit_cast(bf16x8, w); }
#pragma unroll
                for (int s2 = 0; s2 < 2; ++s2) {
                    const s16x4 a00 = __builtin_amdgcn_ds_read_tr16_b64_v4i16((LAS s16x4*)(vb + offv[0] + (16 * s2) * 128));
                    const s16x4 a01 = __builtin_amdgcn_ds_read_tr16_b64_v4i16((LAS s16x4*)(vb + offv[0] + (16 * s2 + 8) * 128));
                    const s16x4 a10 = __builtin_amdgcn_ds_read_tr16_b64_v4i16((LAS s16x4*)(vb + offv[1] + (16 * s2) * 128));
                    const s16x4 a11 = __builtin_amdgcn_ds_read_tr16_b64_v4i16((LAS s16x4*)(vb + offv[1] + (16 * s2 + 8) * 128));
                    const bf16x8 av0 = {a00[0], a00[1], a00[2], a00[3], a01[0], a01[1], a01[2], a01[3]}, av1 = {a10[0], a10[1], a10[2], a10[3], a11[0], a11[1], a11[2], a11[3]};
                    o0 = __builtin_amdgcn_mfma_f32_32x32x16_bf16(av0, pb[s2], o0, 0, 0, 0);
                    o1 = __builtin_amdgcn_mfma_f32_32x32x16_bf16(av1, pb[s2], o1, 0, 0, 0); }
            }
            VM_WAIT(); __syncthreads();
        }
        {   const float lt = lrun + __shfl_xor(lrun, 32), inv = 1.0f / lt;
            bf16* op = Ag + (rowb + t0 + q) * 512 + h * 64 + 4 * hf2;
#pragma unroll
            for (int g = 0; g < 4; ++g) {
                *(unsigned long long*)(op + 8 * g) = (unsigned long long)pg8::cvt_pk_bf16(o0[4 * g] * inv, o0[4 * g + 1] * inv) | ((unsigned long long)pg8::cvt_pk_bf16(o0[4 * g + 2] * inv, o0[4 * g + 3] * inv) << 32);
                *(unsigned long long*)(op + 32 + 8 * g) = (unsigned long long)pg8::cvt_pk_bf16(o1[4 * g] * inv, o1[4 * g + 1] * inv) | ((unsigned long long)pg8::cvt_pk_bf16(o1[4 * g + 2] * inv, o1[4 * g + 3] * inv) << 32); } }
    }
}

__device__ __forceinline__ void final_norm(Frame& F, const Args& a) {
    const float* SS = (const float*)(a.ws + WS_SS); const float* g = a.in[15]; float* out = a.out;
    const int gw = F.vcu * NWAVES + F.wave, NGW = F.G * NWAVES;
    for (int m = gw; m < M; m += NGW) {
        const f32x4 s0 = *(const f32x4*)(SS + (size_t)m * 16), s1 = *(const f32x4*)(SS + (size_t)m * 16 + 4), s2 = *(const f32x4*)(SS + (size_t)m * 16 + 8), s3 = *(const f32x4*)(SS + (size_t)m * 16 + 12);
        const f32x4 st = (s0 + s1) + (s2 + s3); const float rstd = 1.f / sqrtf(((st[0] + st[1]) + (st[2] + st[3])) * (1.f / D) + 1e-6f);
        GAS f32x4* o = (GAS f32x4*)(out + (size_t)m * D) + F.lane;
#pragma unroll
        for (int j = 0; j < 4; ++j) { const f32x4 gv = ((const GAS f32x4*)g)[F.lane + 64 * j]; o[64 * j] = o[64 * j] * rstd * gv; }
    }
}

__global__ void __launch_bounds__(NWAVES * 64, 2) mk_fwd(Args args) {
    extern __shared__ __attribute__((aligned(16))) unsigned char lds[];
    Frame F;
    F.lds = (LAS unsigned char*)lds; F.MISC = (volatile LAS unsigned*)(F.lds + MISC_OFF);
    F.tid = threadIdx.x; F.lane = F.tid & 63; F.wave = __builtin_amdgcn_readfirstlane(F.tid >> 6);
    F.G = gridDim.x; { const int bx = blockIdx.x; F.vcu = (F.G % 8 == 0) ? (bx % 8) * (F.G / 8) + bx / 8 : bx; }
    unsigned char* ws = args.ws;
    F.ctl = (gu32*)(ws + WS_CTL);
    for (int u = F.tid; u < (LDS_BYTES - LDSCTL_OFF) / 4; u += NWAVES * 64) ((LAS unsigned*)(F.lds + LDSCTL_OFF))[u] = 0u;
    __syncthreads();
    XcdBarrier bar; bar.bar = (unsigned*)(F.ctl + CW_BAR); bar.x = 0; bar.st = nullptr;
    if (MK_N_LAUNCHES == 1) bar = xcd_barrier_post((unsigned*)(F.ctl + CW_BAR), F.MISC + 8);
    const int lo = args.ph_lo, hi = args.ph_hi;
#define IN(k) (lo <= (k) && (k) < hi)
#define GRID_BAR(k) do { if (IN(k) && IN((k) + 1)) xcd_barrier(bar); } while (0)
    bf16* R2 = (bf16*)(ws + WS_R2); bf16* Gt = (bf16*)(ws + WS_G); bf16* MG = (bf16*)(ws + WS_MG); float* SS = (float*)(ws + WS_SS);
    if (IN(0)) { p0_prologue(F, args); GRID_BAR(0); }
    if (IN(1)) {
        pg8::Gemm g{R2, (const bf16*)(ws + WS_WIN), M, NU, D}; pg8::StaticOrder S; S.init(M, NU, F.G, (int)blockIdx.x);
        pg8::EpiU E{(bf16*)(ws + WS_GLU), (bf16*)(ws + WS_Q), (bf16*)(ws + WS_QI), (bf16*)(ws + WS_K), (bf16*)(ws + WS_V), (bf16*)(ws + WS_KI), Gt, (float*)(ws + WS_WI), args.in[3], QSC};
        pg8::gemm_phase<pg8::EpiU, pg8::StaticOrder, false, true>(F.lds + RING_OFF, g, S, E);
        GRID_BAR(1);
    }
    if (IN(2)) { conv_phase(F, args); attn_phase(F, args); GRID_BAR(2); }
    if (IN(3)) {
        { pg8::Gemm g{(const bf16*)(ws + WS_C), (const bf16*)(ws + WS_WCO), M, D, CC}; pg8::StaticOrder S; S.init(M, D, F.G, (int)blockIdx.x);
          pg8::EpiMix<false> E{Gt, R2, MG}; pg8::gemm_phase<pg8::EpiMix<false>, pg8::StaticOrder, false, true>(F.lds + RING_OFF, g, S, E); }
        { pg8::Gemm g{(const bf16*)(ws + WS_A), (const bf16*)(ws + WS_WAO), M, D, CC}; pg8::StaticOrder S; S.init(M, D, F.G, (int)blockIdx.x);
          pg8::EpiMix<true> E{Gt, R2, MG}; pg8::gemm_phase<pg8::EpiMix<true>, pg8::StaticOrder, false, true>(F.lds + RING_OFF, g, S, E); }
        GRID_BAR(3);
    }
    if (IN(4)) {
        pg8::Gemm g{MG, (const bf16*)(ws + WS_WOUT), M, D, D}; pg8::StaticOrder S; S.init(M, D, F.G, (int)blockIdx.x);
        pg8::EpiRes<true> E{args.in[0], args.out, R2, SS}; pg8::gemm_phase<pg8::EpiRes<true>, pg8::StaticOrder, false, true>(F.lds + RING_OFF, g, S, E);
        GRID_BAR(4);
    }
    if (IN(5)) {
        pg8::Gemm g{R2, (const bf16*)(ws + WS_WGU), M, 2 * DFF, D}; pg8::StaticOrder S; S.init(M, 2 * DFF, F.G, (int)blockIdx.x);
        pg8::EpiFF E{(bf16*)(ws + WS_HFF), SS, DFF}; pg8::gemm_phase<pg8::EpiFF, pg8::StaticOrder, false, true>(F.lds + RING_OFF, g, S, E);
        GRID_BAR(5);
    }
    if (IN(6)) {
        pg8::Gemm g{(const bf16*)(ws + WS_HFF), (const bf16*)(ws + WS_WD), M, D, DFF}; pg8::StaticOrder S; S.init(M, D, F.G, (int)blockIdx.x);
        pg8::EpiRes<false> E{args.out, args.out, nullptr, SS}; pg8::gemm_phase<pg8::EpiRes<false>, pg8::StaticOrder, false, true>(F.lds + RING_OFF, g, S, E);
        GRID_BAR(6);
    }
    if (IN(7)) final_norm(F, args);
#undef IN
#undef GRID_BAR
}


#ifndef MK_DIGEST
#define MK_DIGEST 0
#endif
__global__ void digest_k(const unsigned char* ws, float* out, int which) {
    const size_t i = (size_t)blockIdx.x * blockDim.x + threadIdx.x; if (i >= (size_t)M * D) return;
    const size_t m = i / D; const int c = (int)(i % D); float v = 0.f;
    if (which == 1) {
        const bf16* G = (const bf16*)(ws + WS_G); v += bf2f(G[m * 2048 + c]) + 2.f * bf2f(G[m * 2048 + 1024 + c]);
        v += 3.f * bf2f(((const bf16*)(ws + WS_GLU))[m * 512 + (c & 511)]) + 5.f * bf2f(((const bf16*)(ws + WS_Q))[m * 512 + (c & 511)]) + 7.f * bf2f(((const bf16*)(ws + WS_QI))[m * 512 + (c & 511)]);
        v += 11.f * bf2f(((const bf16*)(ws + WS_K))[m * 64 + (c & 63)]) + 13.f * bf2f(((const bf16*)(ws + WS_V))[m * 64 + (c & 63)]) + 17.f * bf2f(((const bf16*)(ws + WS_KI))[m * 64 + (c & 63)]) + 19.f * ((const float*)(ws + WS_WI))[m * 8 + (c & 7)];
    } else if (which == 2) {
        v = (c < 512) ? bf2f(((const bf16*)(ws + WS_C))[m * 512 + c]) : bf2f(((const bf16*)(ws + WS_A))[m * 512 + c - 512]);
    } else if (which == 3) {
        v = bf2f(((const bf16*)(ws + WS_MG))[m * 1024 + c]);
    } else if (which == 0) {
        v = bf2f(((const bf16*)(ws + WS_R2))[m * 1024 + c]) + bf2f(((const bf16*)(ws + WS_WIN))[(m % 4352) * 1024 + c]) + bf2f(((const bf16*)(ws + WS_WGU))[(m % 5632) * 1024 + c]) + bf2f(((const bf16*)(ws + WS_WD))[(size_t)(m % 1024) * 2816 + c]);
    }
    out[i] = v;
}

extern "C" void kernel_launch(void* const* d_in, const int* in_sizes, int n_in, void* d_out, int out_size, void* d_ws, size_t ws_size, hipStream_t stream) {
    static int grid = 0;
    if (grid == 0) {
        if (n_in != 16 || in_sizes[0] != M * D || out_size != M * D || ws_size < WS_END) { fprintf(stderr, "kernel_launch: unexpected problem shape (n_in %d, in0 %d, out %d, ws %zu)\n", n_in, n_in > 0 ? in_sizes[0] : -1, out_size, ws_size); grid = -1; return; }
        int dev = 0, cus = 0, per_cu = 0;
        if (hipGetDevice(&dev) != hipSuccess || hipDeviceGetAttribute(&cus, hipDeviceAttributeMultiprocessorCount, dev) != hipSuccess) { grid = -1; return; }
        if (hipFuncSetAttribute((const void*)mk_fwd, hipFuncAttributeMaxDynamicSharedMemorySize, LDS_BYTES) != hipSuccess) { fprintf(stderr, "kernel_launch: hipFuncSetAttribute failed\n"); grid = -1; return; }
        if (hipOccupancyMaxActiveBlocksPerMultiprocessor(&per_cu, (const void*)mk_fwd, NWAVES * 64, LDS_BYTES) != hipSuccess || per_cu < 1) { fprintf(stderr, "kernel_launch: occupancy query says %d blocks per CU\n", per_cu); per_cu = 1; }
        (void)hipGetLastError();
        grid = cus;
    }
    if (grid < 0) return;
    if (hipMemsetAsync((char*)d_ws + WS_CTL, 0, CTL_ZERO_BYTES, stream) != hipSuccess) return;
    Args a{};
    for (int i = 0; i < 16; ++i) a.in[i] = (const float*)d_in[i];
    a.out = (float*)d_out; a.ws = (unsigned char*)d_ws;
    if (MK_N_LAUNCHES == 1) { a.ph_lo = 0; a.ph_hi = N_PHASES; hipLaunchKernelGGL(mk_fwd, dim3(grid), dim3(NWAVES * 64), LDS_BYTES, stream, a); }
    else for (int p = 0; p < (MK_DIGEST ? MK_DIGEST : N_PHASES); ++p) { a.ph_lo = p; a.ph_hi = p + 1; hipLaunchKernelGGL(mk_fwd, dim3(grid), dim3(NWAVES * 64), LDS_BYTES, stream, a); }
    if (MK_DIGEST) hipLaunchKernelGGL(digest_k, dim3((unsigned)(((size_t)M * D + 255) / 256)), dim3(256), 0, stream, (const unsigned char*)d_ws, (float*)d_out, MK_DIGEST - 1);
    const hipError_t le = hipPeekAtLastError();
    if (le != hipSuccess) fprintf(stderr, "kernel_launch: launch failed: %s\n", hipGetErrorName(le));
}
```
